# Optimizing an MI355X kernel written in HIP

```python
import jax, jax.numpy as jnp
from jax import lax
import numpy as np

D_MODEL = 1024
BATCH = 4
SEQ = 4096
DEPTH = 1

N_META = 16
BLOCK = 128
LEAD = BLOCK
FOX_HD = 64
FOX_HEADS = D_MODEL // FOX_HD
FOX_W = FOX_HEADS * FOX_HD
RET_HEADS = 4
RET_DK = D_MODEL // (2 * RET_HEADS)
RET_DV = 2 * RET_DK
RET_QK = RET_HEADS * RET_DK
RET_V = RET_HEADS * RET_DV
D_FF = ((8 * D_MODEL // 3 + 127) // 128) * 128
IN_SIZES = (FOX_W, FOX_W, FOX_W, FOX_HEADS, RET_QK, RET_QK, RET_V, RET_V, D_MODEL, D_MODEL)
N_IN = sum(IN_SIZES)
IN_SPLITS = [int(s) for s in np.cumsum(IN_SIZES)[:-1]]
EPS = 1e-6
GN_EPS = 1e-5
ROPE_BASE = 10000.0
FORGET_BIAS_INIT = 3.0
NEG = -1e30

kernel_name = "fox_retnet_macaron_hybrid"


def rmsnorm(x, g):
    xf = x.astype(jnp.float32)
    y = xf * lax.rsqrt(jnp.mean(xf * xf, axis=-1, keepdims=True) + EPS)
    return (y * g.astype(jnp.float32)).astype(x.dtype)


def swiglu(x, w_in, w_out):
    a, b = jnp.split(x @ w_in, 2, axis=-1)
    return (jax.nn.silu(a) * b) @ w_out


def rotary(x, pos):
    half = x.shape[-1] // 2
    inv = ROPE_BASE ** (-jnp.arange(half, dtype=jnp.float32) / half)
    ang = pos[:, None] * inv[None, :]
    cos, sin = jnp.cos(ang)[None, :, None, :], jnp.sin(ang)[None, :, None, :]
    xf = x.astype(jnp.float32)
    x1, x2 = xf[..., :half], xf[..., half:]
    return jnp.concatenate([x1 * cos - x2 * sin, x2 * cos + x1 * sin], axis=-1)


def forgetting_attention(q, k, v, logf, valid):
    B, H, P, hd = q.shape
    nb = P // BLOCK
    c = jnp.cumsum(logf, axis=-1)
    kpos = jnp.arange(P)
    scale = hd ** -0.5

    def block(i):
        s0 = i * BLOCK
        qb = lax.dynamic_slice_in_dim(q, s0, BLOCK, axis=2)
        cb = lax.dynamic_slice_in_dim(c, s0, BLOCK, axis=2)
        logits = jnp.einsum('bhqd,bhkd->bhqk', qb, k) * scale + cb[..., None] - c[:, :, None, :]
        qpos = s0 + jnp.arange(BLOCK)
        allowed = (kpos[None, :] <= qpos[:, None]) & (valid[None, :] | (kpos[None, :] == qpos[:, None]))
        p = jax.nn.softmax(jnp.where(allowed[None, None], logits, NEG), axis=-1)
        return jnp.einsum('bhqk,bhkd->bhqd', p, v)

    out = lax.map(block, jnp.arange(nb))
    return out.transpose(1, 2, 0, 3, 4).reshape(B, H, P, hd)


def retention(q, k, v, log_gamma):
    B, H, P, dk = q.shape
    dv = v.shape[-1]
    nc = P // BLOCK
    qc = q.reshape(B, H, nc, BLOCK, dk)
    kc = k.reshape(B, H, nc, BLOCK, dk)
    vc = v.reshape(B, H, nc, BLOCK, dv)
    n = jnp.arange(BLOCK, dtype=jnp.float32)
    diff = n[:, None] - n[None, :]
    lg = log_gamma[:, None, None]
    decay = jnp.where(diff >= 0, jnp.exp(lg * jnp.maximum(diff, 0.0)), 0.0)
    scores = jnp.einsum('bhcnd,bhcmd->bhcnm', qc, kc) * decay[None, :, None]
    out = jnp.einsum('bhcnm,bhcme->bhcne', scores, vc)
    zeta = jnp.exp(log_gamma[:, None] * (BLOCK - 1 - n)[None, :])
    kv = jnp.einsum('bhcmd,bhcme->cbhde', kc * zeta[None, :, None, :, None], vc)
    chunk_decay = jnp.exp(log_gamma * BLOCK)[None, :, None, None]

    def step(R, kv_c):
        return chunk_decay * R + kv_c, R

    _, r_prev = lax.scan(step, jnp.zeros((B, H, dk, dv), jnp.float32), kv)
    xi = jnp.exp(log_gamma[:, None] * (n + 1.0)[None, :])
    out = out + jnp.einsum('bhcnd,cbhde->bhcne', qc * xi[None, :, None, :, None], r_prev)
    return out.reshape(B, H, P, dv)


def head_groupnorm(y, g):
    mu = jnp.mean(y, axis=-1, keepdims=True)
    var = jnp.mean(jnp.square(y - mu), axis=-1, keepdims=True)
    yn = (y - mu) * lax.rsqrt(var + GN_EPS)
    B, H, P, dv = y.shape
    return yn.transpose(0, 2, 1, 3).reshape(B, P, H * dv) * g.astype(jnp.float32)


def hybrid_layer(h, valid, pos, log_gamma, norm_ffn1, w_ffn1_in, w_ffn1_out, norm_mix, w_in,
                 b_forget, b_gate, fox_q_norm, fox_k_norm, w_o_fox, ret_gn, w_o_ret, w_out,
                 norm_ffn2, w_ffn2_in, w_ffn2_out):
    dt = h.dtype
    B, P, _ = h.shape
    h = h + 0.5 * swiglu(rmsnorm(h, norm_ffn1), w_ffn1_in, w_ffn1_out)
    u = rmsnorm(h, norm_mix)
    fq, fk, fv, ff, rq, rk, rv, rg, ga, gb = jnp.split(u @ w_in, IN_SPLITS, axis=-1)
    vmask = valid[None, :, None, None].astype(jnp.float32)

    def fox_heads(t):
        return t.reshape(B, P, FOX_HEADS, FOX_HD)
    q_a = rmsnorm(fox_heads(fq), fox_q_norm).astype(jnp.float32).transpose(0, 2, 1, 3)
    k_a = rmsnorm(fox_heads(fk), fox_k_norm).astype(jnp.float32).transpose(0, 2, 1, 3)
    v_a = fox_heads(fv).astype(jnp.float32).transpose(0, 2, 1, 3)
    logf = jax.nn.log_sigmoid(ff.astype(jnp.float32) + b_forget.astype(jnp.float32))
    logf = jnp.where(valid[None, :, None], logf, 0.0).transpose(0, 2, 1)
    y_a = forgetting_attention(q_a, k_a, v_a, logf, valid)
    y_a = y_a.transpose(0, 2, 1, 3).reshape(B, P, FOX_W).astype(dt)

    q_b = rotary(rq.reshape(B, P, RET_HEADS, RET_DK), pos).transpose(0, 2, 1, 3)
    k_b = (rotary(rk.reshape(B, P, RET_HEADS, RET_DK), pos) * (RET_DK ** -0.5) * vmask).transpose(0, 2, 1, 3)
    v_b = (rv.reshape(B, P, RET_HEADS, RET_DV).astype(jnp.float32) * vmask).transpose(0, 2, 1, 3)
    y_b = head_groupnorm(retention(q_b, k_b, v_b, log_gamma), ret_gn)
    y_b = (jax.nn.silu(rg.astype(jnp.float32)) * y_b).astype(dt)

    g_a = jax.nn.sigmoid(ga + b_gate[:D_MODEL])
    g_b = jax.nn.sigmoid(gb + b_gate[D_MODEL:])
    mixed = g_a * (y_a @ w_o_fox) + g_b * (y_b @ w_o_ret)
    h = h + mixed @ w_out

    h = h + 0.5 * swiglu(rmsnorm(h, norm_ffn2), w_ffn2_in, w_ffn2_out)
    return h


def setup_inputs(seed: int = 0) -> dict:
    key = jax.random.key(seed)
    ks = jax.random.split(key, 20)
    f32 = jnp.float32

    def w(k, shape, fan_in):
        return jax.random.normal(k, shape, f32) * fan_in ** -0.5

    def gain(k, shape):
        return 1.0 + 0.01 * jax.random.normal(k, shape, f32)

    L = DEPTH
    return {
        "x": jax.random.normal(ks[0], (BATCH, SEQ, D_MODEL), f32),
        "meta_tokens": jax.random.normal(ks[1], (N_META, D_MODEL), f32),
        "norm_ffn1": gain(ks[2], (L, D_MODEL)),
        "w_ffn1_in": w(ks[3], (L, D_MODEL, 2 * D_FF), D_MODEL),
        "w_ffn1_out": w(ks[4], (L, D_FF, D_MODEL), D_FF),
        "norm_mix": gain(ks[5], (L, D_MODEL)),
        "w_in": w(ks[6], (L, D_MODEL, N_IN), D_MODEL),
        "b_forget": FORGET_BIAS_INIT + 0.1 * jax.random.normal(ks[7], (L, FOX_HEADS), f32),
        "b_gate": 0.01 * jax.random.normal(ks[8], (L, 2 * D_MODEL), f32),
        "fox_q_norm": gain(ks[9], (L, FOX_HD)),
        "fox_k_norm": gain(ks[10], (L, FOX_HD)),
        "w_o_fox": w(ks[11], (L, FOX_W, D_MODEL), FOX_W),
        "ret_gn": gain(ks[12], (L, RET_V)),
        "w_o_ret": w(ks[13], (L, RET_V, D_MODEL), RET_V),
        "w_out": w(ks[14], (L, D_MODEL, D_MODEL), D_MODEL),
        "norm_ffn2": gain(ks[15], (L, D_MODEL)),
        "w_ffn2_in": w(ks[16], (L, D_MODEL, 2 * D_FF), D_MODEL),
        "w_ffn2_out": w(ks[17], (L, D_FF, D_MODEL), D_FF),
    }


def reference(x, meta_tokens, norm_ffn1, w_ffn1_in, w_ffn1_out, norm_mix, w_in, b_forget, b_gate,
              fox_q_norm, fox_k_norm, w_o_fox, ret_gn, w_o_ret, w_out, norm_ffn2, w_ffn2_in,
              w_ffn2_out):
    B, S, D = x.shape
    n_empty = LEAD - N_META
    h = jnp.concatenate([
        jnp.zeros((B, n_empty, D), x.dtype),
        jnp.broadcast_to(meta_tokens.astype(x.dtype)[None], (B, N_META, D)),
        x], axis=1)
    P = h.shape[1]
    idx = jnp.arange(P)
    valid = idx >= n_empty
    pos = (idx - n_empty).astype(jnp.float32)
    log_gamma = jnp.log1p(-jnp.exp2(-5.0 - jnp.arange(RET_HEADS, dtype=jnp.float32)))
    for l in range(DEPTH):
        h = hybrid_layer(h, valid, pos, log_gamma, norm_ffn1[l], w_ffn1_in[l], w_ffn1_out[l],
                         norm_mix[l], w_in[l], b_forget[l], b_gate[l], fox_q_norm[l], fox_k_norm[l],
                         w_o_fox[l], ret_gn[l], w_o_ret[l], w_out[l], norm_ffn2[l], w_ffn2_in[l],
                         w_ffn2_out[l])
    return h[:, LEAD:]
```

```cpp
#include <hip/hip_runtime.h>
#include <hip/hip_cooperative_groups.h>
#include <hip/hip_bf16.h>
#include <cstdio>
#include <cstdint>
#include <cmath>
namespace cg = cooperative_groups;

#ifndef LAST_PHASE
#define LAST_PHASE 12
#endif

#define LAS __attribute__((address_space(3)))
typedef unsigned short bf16_t;
typedef short bf16x8 __attribute__((ext_vector_type(8)));
typedef float f32x4 __attribute__((ext_vector_type(4)));
typedef float f32x16 __attribute__((ext_vector_type(16)));
typedef unsigned u32x4 __attribute__((ext_vector_type(4)));
typedef unsigned u32x2 __attribute__((ext_vector_type(2)));
typedef short s16x4 __attribute__((ext_vector_type(4)));

constexpr int DM = 1024, NB = 4, SEQ = 4096, PP = 4224, MP = NB * PP  , DFF = 2816, NINC = 8208;
constexpr int NMP = MP / 256  , NMR = 64;
constexpr float LOG2E = 1.4426950408889634f;
constexpr float QC2 = 0.125f * LOG2E;

constexpr size_t MiB = 1u << 20;
constexpr size_t WS_SSQ1 = 1 * MiB, WS_SSQ2 = 2 * MiB + 256 * 1024, WS_SSQ0 = 3 * MiB + 512 * 1024, WS_LOGF = 4 * MiB + 768 * 1024;
constexpr size_t WS_COS = 6 * MiB, WS_SIN = 7 * MiB + 256 * 1024;
constexpr size_t WS_W1A = 9 * MiB, WS_W1B = 20 * MiB, WS_WIN = 25 * MiB + 512 * 1024, WS_WOF = 42 * MiB, WS_WOR = 44 * MiB, WS_WOUT = 46 * MiB;
constexpr size_t WS_W2A = 48 * MiB, WS_W2B = 59 * MiB;
constexpr size_t WS_XB = 65 * MiB;
constexpr size_t WS_BIG = 98 * MiB;
constexpr size_t WS_HID = WS_BIG;
constexpr size_t WS_RQ = WS_BIG, WS_RK = WS_BIG + 16 * MiB + 512 * 1024, WS_KT = WS_BIG + 33 * MiB, WS_VT = WS_BIG + 49 * MiB + 512 * 1024;
constexpr size_t WS_SRG = WS_BIG + 82 * MiB + 512 * 1024, WS_KVR = WS_BIG + 115 * MiB + 512 * 1024;
constexpr size_t WS_Q = WS_BIG, WS_K = WS_BIG + 33 * MiB, WS_V = WS_KVR;
constexpr size_t WS_T1 = WS_K, WS_GB = WS_V;
constexpr size_t WS_KLEAD = 128 * 1024, WS_VLEAD = 384 * 1024;
constexpr size_t WS_C2 = 9 * MiB;
static_assert(WS_KVR + 33 * MiB + 512 * 1024 <= 256 * MiB, "ws map");
constexpr int WIN_RET = 0, WIN_FOX = 3328, WIN_GA = 6400, WIN_GB = 7424, WIN_ROWS = 8448;

struct Params {
    const float* x; const float* meta; const float* n1; const float* w1i; const float* w1o; const float* nm; const float* win;
    const float* bfg; const float* bgate; const float* qn; const float* kn; const float* wof; const float* rgn; const float* wor;
    const float* wout; const float* n2; const float* w2i; const float* w2o;
    float* out; unsigned char* ws;
};

typedef const __attribute__((address_space(4))) Params* KP;
__device__ __forceinline__ Params ldp(KP kp) { Params p; p.x = kp->x; p.meta = kp->meta; p.n1 = kp->n1; p.w1i = kp->w1i; p.w1o = kp->w1o; p.nm = kp->nm; p.win = kp->win; p.bfg = kp->bfg; p.bgate = kp->bgate; p.qn = kp->qn; p.kn = kp->kn; p.wof = kp->wof; p.rgn = kp->rgn; p.wor = kp->wor; p.wout = kp->wout; p.n2 = kp->n2; p.w2i = kp->w2i; p.w2o = kp->w2o; p.out = kp->out; p.ws = kp->ws; return p; }
__device__ __forceinline__ KP kparams() { KP kp = (KP)__builtin_amdgcn_kernarg_segment_ptr(); asm volatile("" : "+s"(kp)); return kp; }
typedef float f32x2c __attribute__((ext_vector_type(2))); typedef __bf16 bf16x2c __attribute__((ext_vector_type(2)));
__device__ __forceinline__ unsigned cvt_pk_bf16(float lo, float hi) { const f32x2c v = {lo, hi}; const bf16x2c b = __builtin_convertvector(v, bf16x2c); return __builtin_bit_cast(unsigned, b); }
__device__ __forceinline__ float bf_lo(unsigned w) { return __uint_as_float(w << 16); }
__device__ __forceinline__ float bf_hi(unsigned w) { return __uint_as_float(w & 0xffff0000u); }
__device__ __forceinline__ float silu_f(float v) { return v * __builtin_amdgcn_rcpf(1.0f + __builtin_amdgcn_exp2f(-v * LOG2E)); }
__device__ __forceinline__ float sigm_f(float v) { return __builtin_amdgcn_rcpf(1.0f + __builtin_amdgcn_exp2f(-v * LOG2E)); }
__device__ __forceinline__ u32x4 pack8(f32x4 a, f32x4 b) { u32x4 w; w.x = cvt_pk_bf16(a[0], a[1]); w.y = cvt_pk_bf16(a[2], a[3]); w.z = cvt_pk_bf16(b[0], b[1]); w.w = cvt_pk_bf16(b[2], b[3]); return w; }
__device__ __forceinline__ u32x2 pack4(f32x4 a) { u32x2 w; w.x = cvt_pk_bf16(a[0], a[1]); w.y = cvt_pk_bf16(a[2], a[3]); return w; }
__device__ __forceinline__ float row_rstd(const float* ssq, int row, int fq) {
    const f32x4 v = *(const f32x4*)(ssq + (size_t)row * 16 + 4 * fq);
    float s = (v[0] + v[1]) + (v[2] + v[3]);
    s += __shfl_xor(s, 16); s += __shfl_xor(s, 32);
    return rsqrtf(s * (1.0f / 1024.0f) + 1e-6f);
}
__device__ __forceinline__ float wave_sum(float v) {
#pragma unroll
    for (int o = 1; o < 64; o <<= 1) v += __shfl_xor(v, o);
    return v;
}
#define LDS_WAIT() asm volatile("s_waitcnt lgkmcnt(0)" ::: "memory")

namespace pg8 {
constexpr int BM = 256, BK = 64, HALF = 128, HTB = HALF * BK * 2, NXCD = 8, WGM = 4;
__device__ __forceinline__ int lds_byte(int r, int c) { const int st = (r >> 4) * 2 + (c >> 5), rr = r & 15, cc = c & 31, ob = rr * 64 + cc * 2; return st * 1024 + (ob ^ (((ob >> 9) & 1) << 5)); }
__device__ __forceinline__ void stage_rc(int b, int& R, int& C) { const int st = b / 1024, sb = b % 1024, swz = sb ^ (((sb >> 9) & 1) << 5); R = (st >> 1) * 16 + swz / 64; C = (st & 1) * 32 + (swz % 64) / 2; }
__device__ __forceinline__ int perm32(int rho) { const int n = rho >> 4, i = rho & 15; return 8 * (i >> 2) + 4 * n + (i & 3); }

struct Unit { const char* a; const char* b; unsigned meta; };

enum Kind { K_SWIGLU = 0, K_RES1, K_RES2, K_FINAL, K_RQ, K_RK, K_RV, K_RG, K_FF, K_FQ, K_FK, K_FV, K_GA, K_MIXA, K_GB, K_MIXB };
enum GPhase { GP_G1 = 0, GP_G2, GP_G3R, GP_G3F, GP_MIX, GP_OUT, GP_F2A, GP_F2B };

struct Sched {
    int gp, G, c;
    __device__ __forceinline__ void init(int gp_, int G_, int c_) { gp = gp_; G = G_; c = c_; }
    __device__ __forceinline__ int kdim() const { return (gp == GP_G2 || gp == GP_F2B) ? DFF : 1024; }
    __device__ __forceinline__ bool next(int i, Unit& u) const {
        int nN, nM = NMR, real = 1, chain = 1;
        switch (gp) {
            case GP_G1: nN = 22; nM = NMP; real = 0; break;
            case GP_G2: nN = 4; break;
            case GP_G3R: nN = 13; break;
            case GP_G3F: nN = 12; break;
            case GP_MIX: nN = 4; chain = 4; break;
            case GP_OUT: nN = 4; break;
            case GP_F2A: nN = 22; break;
            default: nN = 4; break;
        }
        const int K = kdim(), nwg = nM * nN;
        const int ti = (chain == 4) ? (i >> 2) : i, sub = (chain == 4) ? (i & 3) : 0;
        const long L = (long)ti * G + c;
        if (gp == GP_G3R && L >= nwg) {
            const int j = (int)(L - nwg); if (j >= 15) return false;
            int kind, aux, brow;
            if (j < 2) { kind = K_RK; aux = j; brow = WIN_RET + (2 + j) * 256; } else if (j < 6) { kind = K_RV; aux = j - 2; brow = WIN_RET + (2 + j) * 256; }
            else if (j == 6) { kind = K_FF; aux = 0; brow = WIN_RET + 12 * 256; } else if (j < 11) { kind = K_FK; aux = (j - 7) | 4; brow = WIN_FOX + (j - 3) * 256; }
            else { kind = K_FV; aux = (j - 11) | 4; brow = WIN_FOX + (j - 3) * 256; }
            u.meta = ((unsigned)kind << 21) | ((unsigned)aux << 25);
            const char* ws = (const char*)kparams()->ws;
            u.a = ws + WS_XB; u.b = ws + WS_WIN + (size_t)brow * K * 2;
            return true;
        }
        if (L >= nwg) return false;
        int wgid = (int)L; { const int q = nwg / NXCD, r = nwg % NXCD, xcd = wgid % NXCD, off = wgid / NXCD; wgid = (xcd < r ? xcd * (q + 1) : r * (q + 1) + (xcd - r) * q) + off; }
        const int nig = WGM * nN, gid = wgid / nig, fm = gid * WGM, gsz = (nM - fm) < WGM ? (nM - fm) : WGM;
        const int pm = fm + ((wgid % nig) % gsz), pn = (wgid % nig) / gsz;
        const int row0 = real ? ((pm >> 4) * PP + 128 + (pm & 15) * 256) : pm * 256;
        int aux = 0;
        size_t aoff = WS_XB, boff = 0; int brow = pn * 256, kind = 0;
        switch (gp) {
            case GP_G1: boff = WS_W1A; kind = K_SWIGLU; break;
            case GP_G2: aoff = WS_HID; boff = WS_W1B; kind = K_RES1; break;
            case GP_G3R: boff = WS_WIN; brow = WIN_RET + pn * 256;
                if (pn < 2) { kind = K_RQ; aux = pn; } else if (pn < 4) { kind = K_RK; aux = pn - 2; } else if (pn < 8) { kind = K_RV; aux = pn - 4; } else if (pn < 12) { kind = K_RG; aux = pn - 8; } else kind = K_FF;
                break;
            case GP_G3F: boff = WS_WIN; brow = WIN_FOX + pn * 256;
                if (pn < 4) { kind = K_FQ; aux = pn; } else if (pn < 8) { kind = K_FK; aux = pn - 4; } else { kind = K_FV; aux = pn - 8; }
                break;
            case GP_MIX:
                if (sub == 0) { boff = WS_WIN; brow = WIN_GA + pn * 256; kind = K_GA; }
                else if (sub == 1) { aoff = WS_Q; boff = WS_WOF; kind = K_MIXA; }
                else if (sub == 2) { boff = WS_WIN; brow = WIN_GB + pn * 256; kind = K_GB; }
                else { aoff = WS_SRG; boff = WS_WOR; kind = K_MIXB; }
                break;
            case GP_OUT: aoff = WS_T1; boff = WS_WOUT; kind = K_RES2; break;
            case GP_F2A: boff = WS_W2A; kind = K_SWIGLU; aux = 1; break;
            default: aoff = WS_HID; boff = WS_W2B; kind = K_FINAL; break;
        }
        u.meta = (unsigned)row0 | ((unsigned)pn << 16) | ((unsigned)kind << 21) | ((unsigned)aux << 25);
        const char* ws = (const char*)kparams()->ws;
        u.a = ws + aoff + (size_t)row0 * K * 2;
        u.b = ws + boff + (size_t)brow * K * 2;
        return true;
    }
};

struct Epi {
    __device__ __forceinline__ void operator()(const f32x4 (&acc)[2][2][4][2], const Unit& u, int wr, int wc, int fr, int fq) const {
        asm volatile("" : "+v"(fr), "+v"(fq), "+s"(wr), "+s"(wc));
        const KP kp = kparams();
        unsigned char* ws = kp->ws;
        const int kind = (u.meta >> 21) & 15, pn = (u.meta >> 16) & 31, u_aux = (u.meta >> 25) & 7, u_row0 = u.meta & 0xffff, u_col0 = pn << 8;
        float rsv[2][4];
        if (!(kind == K_RES1 || kind == K_RES2 || kind == K_FINAL || kind == K_MIXA || kind == K_MIXB)) {
            const float* ssqp = (const float*)(ws + (kind == K_SWIGLU ? (u_aux ? WS_SSQ2 : WS_SSQ0) : WS_SSQ1));
            f32x4 sv[2][4];
#pragma unroll
            for (int ai = 0; ai < 2; ++ai)
#pragma unroll
                for (int m = 0; m < 4; ++m) sv[ai][m] = *(const f32x4*)(ssqp + (size_t)(u_row0 + ai * 128 + wr * 64 + m * 16 + fr) * 16 + 4 * fq);
#pragma unroll
            for (int ai = 0; ai < 2; ++ai)
#pragma unroll
                for (int m = 0; m < 4; ++m) { float sx = (sv[ai][m][0] + sv[ai][m][1]) + (sv[ai][m][2] + sv[ai][m][3]); sx += __shfl_xor(sx, 16); sx += __shfl_xor(sx, 32); rsv[ai][m] = rsqrtf(sx * (1.0f / 1024.0f) + 1e-6f); }
        } else {
#pragma unroll
            for (int ai = 0; ai < 2; ++ai)
#pragma unroll
                for (int m = 0; m < 4; ++m) rsv[ai][m] = 1.0f;
        }
#define FOR_ROWS _Pragma("unroll") for (int ai = 0; ai < 2; ++ai) _Pragma("unroll") for (int m = 0; m < 4; ++m)
#define ROWDEF const int row = u_row0 + ai * 128 + wr * 64 + m * 16 + fr
        if (kind == K_SWIGLU) {
            const float* ssq = (const float*)(ws + (u_aux ? WS_SSQ2 : WS_SSQ0));
            bf16_t* H = (bf16_t*)(ws + WS_HID);
            const int hc = (u_col0 >> 1) + wc * 32 + 8 * fq;
            FOR_ROWS { ROWDEF; const float rs = rsv[ai][m];
                f32x4 o[2];
#pragma unroll
                for (int n = 0; n < 2; ++n) { const f32x4 a = acc[ai][0][m][n] * rs, b = acc[ai][1][m][n] * rs;
#pragma unroll
                    for (int e = 0; e < 4; ++e) o[n][e] = silu_f(a[e]) * b[e]; }
                *(u32x4*)(H + (size_t)row * DFF + hc) = pack8(o[0], o[1]); }
        } else if (kind == K_RES1 || kind == K_RES2 || kind == K_FINAL) {
            float* ssq = (float*)(ws + (kind == K_RES1 ? WS_SSQ1 : WS_SSQ2));
            bf16_t* HB = (bf16_t*)(ws + WS_XB);
            const float sc = (kind == K_RES2) ? 1.0f : 0.5f;
            const int c0 = u_col0 + wc * 32 + 8 * fq;
#pragma unroll
            for (int aim = 0; aim < 4; ++aim) { const int ai = aim >> 1, m0 = 2 * (aim & 1);
                f32x4 bs[4][2][2]; u32x4 hb[4][2];
#pragma unroll
                for (int m = m0; m < m0 + 2; ++m) { ROWDEF; const int b = row / PP, pidx = row - b * PP;
                    if (kind == K_RES1) { const float* ip = kp->x + ((size_t)(b * SEQ + pidx - 128)) * DM + c0;
#pragma unroll
                        for (int bj = 0; bj < 2; ++bj) { bs[m][bj][0] = *(const f32x4*)(ip + bj * 128); bs[m][bj][1] = *(const f32x4*)(ip + bj * 128 + 4); hb[m][bj] = (u32x4){0u, 0u, 0u, 0u}; }
                    } else {
#pragma unroll
                        for (int bj = 0; bj < 2; ++bj) { hb[m][bj] = *(const u32x4*)(HB + (size_t)row * DM + c0 + bj * 128); bs[m][bj][0] = (f32x4){0.f, 0.f, 0.f, 0.f}; bs[m][bj][1] = bs[m][bj][0]; }
                    } }
                asm volatile("" ::: "memory");
#pragma unroll
                for (int m = m0; m < m0 + 2; ++m) { ROWDEF; const int b = row / PP, pidx = row - b * PP; float ss = 0.f;
                    float* op = kp->out + ((size_t)(b * SEQ + pidx - 128)) * DM + c0;
#pragma unroll
                    for (int bj = 0; bj < 2; ++bj) {
                        f32x4 b0 = bs[m][bj][0], b1 = bs[m][bj][1];
                        if (kind != K_RES1) { const u32x4 t = hb[m][bj]; b0 = (f32x4){bf_lo(t.x), bf_hi(t.x), bf_lo(t.y), bf_hi(t.y)}; b1 = (f32x4){bf_lo(t.z), bf_hi(t.z), bf_lo(t.w), bf_hi(t.w)}; }
                        const f32x4 v0 = b0 + acc[ai][bj][m][0] * sc, v1 = b1 + acc[ai][bj][m][1] * sc;
                        if (kind == K_FINAL) { *(f32x4*)(op + bj * 128) = v0; *(f32x4*)(op + bj * 128 + 4) = v1; }
                        else { *(u32x4*)(HB + (size_t)row * DM + c0 + bj * 128) = pack8(v0, v1);
                            ss += (v0[0] * v0[0] + v0[1] * v0[1]) + (v0[2] * v0[2] + v0[3] * v0[3]) + (v1[0] * v1[0] + v1[1] * v1[1]) + (v1[2] * v1[2] + v1[3] * v1[3]); }
                    }
                    if (kind != K_FINAL) { ss += __shfl_xor(ss, 16); ss += __shfl_xor(ss, 32);
                        if (fq == 0) ssq[(size_t)row * 16 + pn * 4 + wc] = ss; } }
            }
        } else if (kind == K_RQ || kind == K_RK) {
            const float* ssq = (const float*)(ws + WS_SSQ1);
            const float* COS = (const float*)(ws + WS_COS); const float* SIN = (const float*)(ws + WS_SIN);
            const int hh = wc >> 1, i0 = 32 * (wc & 1) + 8 * fq, hd = 2 * u_aux + hh;
            bf16_t* RQ = (bf16_t*)(ws + (kind == K_RQ ? WS_RQ : WS_RK)); bf16_t* KT = (bf16_t*)(ws + WS_KT);
#pragma unroll
            for (int aim = 0; aim < 4; ++aim) { const int ai = aim >> 1, m0 = 2 * (aim & 1);
                f32x4 csv[4][2], snv[4][2];
#pragma unroll
                for (int m = m0; m < m0 + 2; ++m) { ROWDEF; const int b = row / PP, pidx = row - b * PP;
#pragma unroll
                    for (int n = 0; n < 2; ++n) { csv[m][n] = *(const f32x4*)(COS + (size_t)pidx * 64 + i0 + 4 * n); snv[m][n] = *(const f32x4*)(SIN + (size_t)pidx * 64 + i0 + 4 * n); } }
#pragma unroll
                for (int m = m0; m < m0 + 2; ++m) { ROWDEF; const float rs = rsv[ai][m]; const int b = row / PP, pidx = row - b * PP;
                    const float ksc = (kind == K_RK) ? (pidx >= 112 ? 0.08838834764831845f : 0.f) : 1.0f;
#pragma unroll
                    for (int n = 0; n < 2; ++n) {
                        const f32x4 cs = csv[m][n], sn = snv[m][n];
                        const f32x4 x1 = acc[ai][0][m][n] * rs, x2 = acc[ai][1][m][n] * rs;
                        const f32x4 y1 = (x1 * cs - x2 * sn) * ksc, y2 = (x2 * cs + x1 * sn) * ksc;
                        bf16_t* o = RQ + (size_t)row * 512 + hd * 128 + i0 + 4 * n;
                        *(u32x2*)o = pack4(y1); *(u32x2*)(o + 64) = pack4(y2);
                        if (kind == K_RK) {
                            bf16_t* kt = KT + ((size_t)((b * 4 + hd) * 128 + i0 + 4 * n)) * PP + pidx;
#pragma unroll
                            for (int e = 0; e < 4; ++e) { kt[(size_t)e * PP] = (bf16_t)cvt_pk_bf16(y1[e], 0.f); kt[(size_t)(64 + e) * PP] = (bf16_t)cvt_pk_bf16(y2[e], 0.f); }
                        }
                    } }
            }
        } else if (kind == K_RV) {
            const float* ssq = (const float*)(ws + WS_SSQ1); bf16_t* VT = (bf16_t*)(ws + WS_VT); const int hd = u_aux;
            FOR_ROWS { ROWDEF; float rs = rsv[ai][m]; const int b = row / PP, pidx = row - b * PP; if (pidx < 112) rs = 0.f;
#pragma unroll
                for (int bj = 0; bj < 2; ++bj)
#pragma unroll
                    for (int n = 0; n < 2; ++n) { const f32x4 v = acc[ai][bj][m][n] * rs; const int e0 = 128 * bj + 32 * wc + 8 * fq + 4 * n;
                        bf16_t* vt = VT + ((size_t)((b * 4 + hd) * 256 + e0)) * PP + pidx;
#pragma unroll
                        for (int e = 0; e < 4; ++e) vt[(size_t)e * PP] = (bf16_t)cvt_pk_bf16(v[e], 0.f); } }
        } else if (kind == K_RG || kind == K_FV) {
            const float* ssq = (const float*)(ws + WS_SSQ1); const bool lead = (u_aux & 4) != 0; bf16_t* O = (bf16_t*)(ws + (kind == K_RG ? WS_SRG : (lead ? WS_VLEAD : WS_V)));
            const int c0 = 256 * (u_aux & 3) + wc * 32 + 8 * fq;
            FOR_ROWS { ROWDEF; const float rs = rsv[ai][m];
#pragma unroll
                for (int bj = 0; bj < 2; ++bj) { f32x4 v0 = acc[ai][bj][m][0] * rs, v1 = acc[ai][bj][m][1] * rs;
                    if (kind == K_RG) {
#pragma unroll
                        for (int e = 0; e < 4; ++e) { v0[e] = silu_f(v0[e]); v1[e] = silu_f(v1[e]); } }
                    if (!lead || row < 128) *(u32x4*)(O + (size_t)row * DM + c0 + bj * 128) = pack8(v0, v1); } }
        } else if (kind == K_FF) {
            const float* ssq = (const float*)(ws + WS_SSQ1); float* LF = (float*)(ws + WS_LOGF);
            float fb[2][4];
#pragma unroll
            for (int n = 0; n < 2; ++n)
#pragma unroll
                for (int e = 0; e < 4; ++e) fb[n][e] = kp->bfg[(8 * fq + 4 * n + e) & 15];
            FOR_ROWS { ROWDEF; const float rs = rsv[ai][m]; const int b = row / PP, pidx = row - b * PP;
                if (wc == 0 && fq < 2) {
#pragma unroll
                    for (int n = 0; n < 2; ++n)
#pragma unroll
                        for (int e = 0; e < 4; ++e) { const int hx = 8 * fq + 4 * n + e; const float v = acc[ai][0][m][n][e] * rs + fb[n][e];
                            const float lf = fminf(v, 0.f) * LOG2E - __builtin_amdgcn_logf(1.0f + __builtin_amdgcn_exp2f(-fabsf(v) * LOG2E));
                            LF[((size_t)(b * 16 + hx)) * PP + pidx] = (pidx >= 112) ? lf : 0.f; } } }
        } else if (kind == K_FQ || kind == K_FK) {
            const float* ssq = (const float*)(ws + WS_SSQ1); const bool lead = (u_aux & 4) != 0; bf16_t* O = (bf16_t*)(ws + (kind == K_FQ ? WS_Q : (lead ? WS_KLEAD : WS_K)));
            const float* gn = (kind == K_FQ) ? kp->qn : kp->kn; const float osc = (kind == K_FQ) ? QC2 : 1.0f;
            const int head = 4 * (u_aux & 3) + wc;
            f32x4 gq[2][2];
#pragma unroll
            for (int bj = 0; bj < 2; ++bj) { gq[bj][0] = *(const f32x4*)(gn + 32 * bj + 8 * fq); gq[bj][1] = *(const f32x4*)(gn + 32 * bj + 8 * fq + 4); }
            FOR_ROWS { ROWDEF; const float rs = rsv[ai][m];
                f32x4 v[2][2]; float ss = 0.f;
#pragma unroll
                for (int bj = 0; bj < 2; ++bj)
#pragma unroll
                    for (int n = 0; n < 2; ++n) { v[bj][n] = acc[ai][bj][m][n] * rs; const f32x4 t = v[bj][n]; ss += (t[0] * t[0] + t[1] * t[1]) + (t[2] * t[2] + t[3] * t[3]); }
                ss += __shfl_xor(ss, 16); ss += __shfl_xor(ss, 32);
                const float r2 = rsqrtf(ss * (1.0f / 64.0f) + 1e-6f) * osc;
#pragma unroll
                for (int bj = 0; bj < 2; ++bj) { const f32x4 g0 = gq[bj][0], g1 = gq[bj][1];
                    if (!lead || row < 128) *(u32x4*)(O + (size_t)row * DM + head * 64 + 32 * bj + 8 * fq) = pack8(v[bj][0] * g0 * r2, v[bj][1] * g1 * r2); } }
        } else if (kind == K_GA || kind == K_GB) {
            bf16_t* O = (bf16_t*)(ws + (kind == K_GA ? WS_T1 : WS_GB));
            const int c0 = u_col0 + wc * 32 + 8 * fq;
            f32x4 gq[2][2];
#pragma unroll
            for (int bj = 0; bj < 2; ++bj) { const float* bg = kp->bgate + (kind == K_GB ? 1024 : 0) + c0 + bj * 128; gq[bj][0] = *(const f32x4*)bg; gq[bj][1] = *(const f32x4*)(bg + 4); }
            FOR_ROWS { ROWDEF; const float rs = rsv[ai][m];
#pragma unroll
                for (int bj = 0; bj < 2; ++bj) { const int c = c0 + bj * 128; f32x4 v0 = acc[ai][bj][m][0], v1 = acc[ai][bj][m][1];
#pragma unroll
                    for (int e = 0; e < 4; ++e) { v0[e] = sigm_f(v0[e] * rs + gq[bj][0][e]); v1[e] = sigm_f(v1[e] * rs + gq[bj][1][e]); }
                    *(u32x4*)(O + (size_t)row * DM + c) = pack8(v0, v1); } }
        } else {
            bf16_t* T1 = (bf16_t*)(ws + WS_T1); bf16_t* GB = (bf16_t*)(ws + WS_GB);
            const int c0 = u_col0 + wc * 32 + 8 * fq;
#pragma unroll
            for (int aim = 0; aim < 4; ++aim) { const int ai = aim >> 1, m0 = 2 * (aim & 1);
                u32x4 tt[4][2], gg[4][2];
#pragma unroll
                for (int m = m0; m < m0 + 2; ++m) { ROWDEF;
#pragma unroll
                    for (int bj = 0; bj < 2; ++bj) { tt[m][bj] = *(const u32x4*)(T1 + (size_t)row * DM + c0 + bj * 128); gg[m][bj] = (u32x4){0u, 0u, 0u, 0u}; if (kind == K_MIXB) gg[m][bj] = *(const u32x4*)(GB + (size_t)row * DM + c0 + bj * 128); } }
#pragma unroll
                for (int m = m0; m < m0 + 2; ++m) { ROWDEF;
#pragma unroll
                    for (int bj = 0; bj < 2; ++bj) { f32x4 v0 = acc[ai][bj][m][0], v1 = acc[ai][bj][m][1]; const u32x4 t = tt[m][bj], g = gg[m][bj];
                        if (kind == K_MIXA) {
                            v0[0] *= bf_lo(t.x); v0[1] *= bf_hi(t.x); v0[2] *= bf_lo(t.y); v0[3] *= bf_hi(t.y); v1[0] *= bf_lo(t.z); v1[1] *= bf_hi(t.z); v1[2] *= bf_lo(t.w); v1[3] *= bf_hi(t.w);
                        } else {
                            v0[0] = bf_lo(t.x) + bf_lo(g.x) * v0[0]; v0[1] = bf_hi(t.x) + bf_hi(g.x) * v0[1]; v0[2] = bf_lo(t.y) + bf_lo(g.y) * v0[2]; v0[3] = bf_hi(t.y) + bf_hi(g.y) * v0[3];
                            v1[0] = bf_lo(t.z) + bf_lo(g.z) * v1[0]; v1[1] = bf_hi(t.z) + bf_hi(g.z) * v1[1]; v1[2] = bf_lo(t.w) + bf_lo(g.w) * v1[2]; v1[3] = bf_hi(t.w) + bf_hi(g.w) * v1[3];
                        }
                        *(u32x4*)(T1 + (size_t)row * DM + c0 + bj * 128) = pack8(v0, v1); } }
            }
        }
#undef FOR_ROWS
#undef ROWDEF
    }
};

__device__ __forceinline__ void gemm_phase(LAS unsigned char* lds, const Sched& S, const Epi& E) {
    int tid_ = threadIdx.x; asm volatile("" : "+v"(tid_));
    const int tid = tid_, wid = __builtin_amdgcn_readfirstlane(tid >> 6), lane = tid & 63, wr = wid >> 2, wc = wid & 3, fr = lane & 15, fq = lane >> 4;
    const int K = S.kdim(), nt = K / BK;
    unsigned voffA[2], voffB[2];
#pragma unroll
    for (int i = 0; i < 2; ++i) { int R, C; stage_rc(tid * 16 + i * 8192, R, C); const int Rb = (R & ~31) + perm32(R & 31);
        voffA[i] = (unsigned)(R * K + C) * 2u; voffB[i] = (unsigned)(Rb * K + C) * 2u; }
    const size_t kstep = (size_t)(BK * 2);
    const size_t hstep = (size_t)HALF * K * 2;
    const unsigned ldsw = (unsigned)wid * 1024u;
    const int aoff = lds_byte(wr * 64 + fr, fq * 8), boff = lds_byte(wc * 32 + fr, fq * 8);
#define PG8_SA(b, h) (((b) * 2 + (h)) * HTB)
#define PG8_SB(b, h) ((4 + (b) * 2 + (h)) * HTB)
#define PG8_STAGE(bufoff, gbase, voff) do { _Pragma("unroll") for (int _i = 0; _i < 2; ++_i) \
        __builtin_amdgcn_global_load_lds((const unsigned*)((const char*)(gbase) + (voff)[_i]), (LAS unsigned*)(lds + (bufoff) + ldsw + _i * 8192), 16, 0, 0); } while (0)
#define PG8_LDA(dst, b, h) do { _Pragma("unroll") for (int m = 0; m < 4; ++m) _Pragma("unroll") for (int k = 0; k < 2; ++k) dst[m][k] = *(const LAS bf16x8*)(lds + PG8_SA(b, h) + aoff + m * 2048 + k * 1024); } while (0)
#define PG8_LDB(dst, b, h) do { _Pragma("unroll") for (int n = 0; n < 2; ++n) _Pragma("unroll") for (int k = 0; k < 2; ++k) dst[n][k] = *(const LAS bf16x8*)(lds + PG8_SB(b, h) + boff + n * 2048 + k * 1024); } while (0)
#define PG8_MMA(ai, bj, At, Bt) do { __builtin_amdgcn_s_setprio(1); _Pragma("unroll") for (int m = 0; m < 4; ++m) _Pragma("unroll") for (int n = 0; n < 2; ++n) _Pragma("unroll") for (int k = 0; k < 2; ++k) \
        acc[ai][bj][m][n] = __builtin_amdgcn_mfma_f32_16x16x32_bf16(Bt[n][k], At[m][k], acc[ai][bj][m][n], 0, 0, 0); __builtin_amdgcn_s_setprio(0); } while (0)
#define PG8_WAIT_V(n) asm volatile("s_waitcnt vmcnt(" #n ")" ::: "memory")
#define PG8_WAIT_L(n) asm volatile("s_waitcnt lgkmcnt(" #n ")" ::: "memory")
#define PG8_BAR __builtin_amdgcn_s_barrier()
#define PG8_SCHED __builtin_amdgcn_sched_barrier(0)
    Unit cur, nxt; int ui = 0;
    if (!S.next(0, cur)) return;
    f32x4 acc[2][2][4][2];
#pragma unroll
    for (int a = 0; a < 2; ++a)
#pragma unroll
        for (int b = 0; b < 2; ++b)
#pragma unroll
            for (int m = 0; m < 4; ++m)
#pragma unroll
                for (int n = 0; n < 2; ++n) acc[a][b][m][n] = (f32x4){0.f, 0.f, 0.f, 0.f};
    bf16x8 At[4][2], B0[2][2], B1[2][2];
    const char* cA = cur.a; const char* cB = cur.b;
    PG8_STAGE(PG8_SB(0, 0), cB, voffB); PG8_STAGE(PG8_SB(0, 1), cB + hstep, voffB); PG8_STAGE(PG8_SA(0, 0), cA, voffA); PG8_STAGE(PG8_SA(0, 1), cA + hstep, voffA);
    if (wr == 1) PG8_BAR;
    PG8_WAIT_V(2); PG8_BAR;
    PG8_STAGE(PG8_SB(1, 0), cB + kstep, voffB); PG8_STAGE(PG8_SA(1, 0), cA + kstep, voffA); PG8_STAGE(PG8_SB(1, 1), cB + hstep + kstep, voffB);
    PG8_WAIT_V(6); PG8_BAR;
    for (;;) {
        const bool has_next = S.next(ui + 1, nxt);
        const char* nA = has_next ? nxt.a : cA; const char* nB = has_next ? nxt.b : cB;
        for (int t = 0; t < nt; t += 2) {
            const bool last = (t == nt - 2);
            const char* a1 = cA + (size_t)(t + 1) * kstep;
            const char* a2 = last ? nA : cA + (size_t)(t + 2) * kstep; const char* b2 = last ? nB : cB + (size_t)(t + 2) * kstep;
            const char* a3 = a2 + kstep; const char* b3 = b2 + kstep;
            PG8_LDB(B0, 0, 0); PG8_LDB(B1, 0, 1); PG8_SCHED; PG8_LDA(At, 0, 0); PG8_STAGE(PG8_SA(1, 1), a1 + hstep, voffA);
            PG8_WAIT_V(8); PG8_WAIT_L(0); PG8_BAR; PG8_MMA(0, 0, At, B0); PG8_MMA(0, 1, At, B1); PG8_BAR; PG8_SCHED;
            PG8_LDA(At, 0, 1); PG8_STAGE(PG8_SB(0, 0), b2, voffB); PG8_STAGE(PG8_SB(0, 1), b2 + hstep, voffB); PG8_STAGE(PG8_SA(0, 0), a2, voffA);
            PG8_WAIT_V(8); PG8_WAIT_L(0); PG8_BAR; PG8_MMA(1, 0, At, B0); PG8_MMA(1, 1, At, B1); PG8_BAR; PG8_SCHED;
            PG8_LDB(B0, 1, 0); PG8_LDB(B1, 1, 1); PG8_SCHED; PG8_LDA(At, 1, 0); PG8_STAGE(PG8_SA(0, 1), a2 + hstep, voffA);
            PG8_WAIT_V(8); PG8_WAIT_L(0); PG8_BAR; PG8_MMA(0, 0, At, B0); PG8_MMA(0, 1, At, B1); PG8_BAR; PG8_SCHED;
            PG8_LDA(At, 1, 1); PG8_STAGE(PG8_SB(1, 0), b3, voffB); PG8_STAGE(PG8_SB(1, 1), b3 + hstep, voffB); PG8_STAGE(PG8_SA(1, 0), a3, voffA);
            PG8_WAIT_V(8); PG8_WAIT_L(0); PG8_BAR; PG8_MMA(1, 0, At, B0); PG8_MMA(1, 1, At, B1); PG8_BAR; PG8_SCHED;
        }
        if (wr == 0) PG8_BAR;
        E(acc, cur, wr, wc, fr, fq);
        if (!has_next) break;
#pragma unroll
        for (int a = 0; a < 2; ++a)
#pragma unroll
            for (int b = 0; b < 2; ++b)
#pragma unroll
                for (int m = 0; m < 4; ++m)
#pragma unroll
                    for (int n = 0; n < 2; ++n) acc[a][b][m][n] = (f32x4){0.f, 0.f, 0.f, 0.f};
        cur = nxt; cA = nA; cB = nB; ++ui;
        if (wr == 1) PG8_BAR;
    }
    PG8_WAIT_V(0);
    PG8_BAR;
#undef PG8_SA
#undef PG8_SB
#undef PG8_STAGE
#undef PG8_LDA
#undef PG8_LDB
#undef PG8_MMA
#undef PG8_WAIT_V
#undef PG8_WAIT_L
#undef PG8_BAR
#undef PG8_SCHED
}
}

namespace attn_body {
using bf16 = __hip_bfloat16;
constexpr int D = 64, NW = 8, QBLK = 32, QB = QBLK * NW, KVBLK = 64;
__device__ __forceinline__ int crow(int r, int hi) { return (r & 3) + 8 * (r >> 2) + 4 * hi; }
#define SBAR() __builtin_amdgcn_sched_barrier(0)
__device__ __forceinline__ void cmask(f32x16& p0, f32x16& p1, int jb, int qrel, int hi) {
    const float NEG = -INFINITY; int kb = 64 * jb + 4 * hi;
#pragma unroll
    for (int r = 0; r < 16; ++r) { int kv = kb + (r & 3) + 8 * (r >> 2); if (kv > qrel) p0[r] = NEG; if (kv + 32 > qrel) p1[r] = NEG; }
}
constexpr int NSLOT = 3, SLOTB = 8192;
constexpr int LDS_K = 0, LDS_V = NSLOT * SLOTB, LDS_WS = 2 * NSLOT * SLOTB, LDS_OST = LDS_WS + NW * 64 * 4, LDS_BYTES = LDS_OST + NW * 4096;
constexpr int LDS_C2 = 86016, LDS_C2T = 103424;
__device__ __forceinline__ void glds16(const void* gsrc, unsigned lds_dst) { unsigned keep;
    asm volatile("s_mov_b32 %0, m0\n\ts_mov_b32 m0, %2\n\ts_nop 0\n\tglobal_load_lds_dwordx4 %1, off\n\ts_mov_b32 m0, %0" : "=&s"(keep) : "v"(gsrc), "s"(lds_dst) : "memory"); }
__device__ __forceinline__ float max3f(float a, float b, float c) { float r; asm("v_max3_f32 %0, %1, %2, %3" : "=v"(r) : "v"(a), "v"(b), "v"(c)); return r; }
__device__ __forceinline__ float max2f(float a, float b) { float r; asm("v_max_f32_e32 %0, %1, %2" : "=v"(r) : "v"(a), "v"(b)); return r; }
__device__ __forceinline__ float fadd_s(float a, float b) { float r; asm("v_add_f32_e32 %0, %1, %2" : "=v"(r) : "v"(a), "v"(b)); return r; }
__device__ __forceinline__ float fsub_s(float a, float b) { float r; asm("v_sub_f32_e32 %0, %1, %2" : "=v"(r) : "v"(a), "v"(b)); return r; }
typedef float f32x2_t __attribute__((ext_vector_type(2))); typedef __bf16 bf16x2_t __attribute__((ext_vector_type(2)));
__device__ __forceinline__ unsigned cvtpk_s(float lo, float hi) { f32x2_t v = {lo, hi}; bf16x2_t b = __builtin_convertvector(v, bf16x2_t); return __builtin_bit_cast(unsigned, b); }
#define WAIT_BAR(N) asm volatile("s_waitcnt vmcnt(" #N ") lgkmcnt(0)\n\ts_barrier" ::: "memory")

__device__ __forceinline__ void qkt(f32x16& p0, f32x16& p1, const char* Kslot, const bf16x8* qr, const f32x16& negm, int r32, int hi) {
    const char* kb = Kslot + hi * 1024 + r32 * 16;
#pragma unroll
    for (int d0 = 0; d0 < 4; ++d0) {
        const bf16x8 b0 = *reinterpret_cast<const bf16x8*>(kb + d0 * 2048);
        const bf16x8 b1 = *reinterpret_cast<const bf16x8*>(kb + d0 * 2048 + 512);
        if (d0 == 0) { p0 = __builtin_amdgcn_mfma_f32_32x32x16_bf16(b0, qr[0], negm, 0, 0, 0); p1 = __builtin_amdgcn_mfma_f32_32x32x16_bf16(b1, qr[0], negm, 0, 0, 0); }
        else { p0 = __builtin_amdgcn_mfma_f32_32x32x16_bf16(b0, qr[d0], p0, 0, 0, 0); p1 = __builtin_amdgcn_mfma_f32_32x32x16_bf16(b1, qr[d0], p1, 0, 0, 0); } }
}
typedef __attribute__((address_space(3))) const char* lds_cptr;
typedef short v4i16_t __attribute__((ext_vector_type(4)));
__device__ __forceinline__ void kload8(bf16x8* kf, lds_cptr kp) {
    kf[0] = *(const LAS bf16x8*)(kp);        kf[1] = *(const LAS bf16x8*)(kp + 512);
    kf[2] = *(const LAS bf16x8*)(kp + 2048); kf[3] = *(const LAS bf16x8*)(kp + 2560);
    kf[4] = *(const LAS bf16x8*)(kp + 4096); kf[5] = *(const LAS bf16x8*)(kp + 4608);
    kf[6] = *(const LAS bf16x8*)(kp + 6144); kf[7] = *(const LAS bf16x8*)(kp + 6656);
}
__device__ __forceinline__ void kload2(bf16x8* kf, lds_cptr kp, int j) { kf[2 * j] = *(const LAS bf16x8*)(kp + j * 2048); kf[2 * j + 1] = *(const LAS bf16x8*)(kp + j * 2048 + 512); }
__device__ __forceinline__ s16x4 vtr(lds_cptr p) { return __builtin_bit_cast(s16x4, __builtin_amdgcn_ds_read_tr16_b64_v4i16((LAS v4i16_t*)p)); }
__device__ __forceinline__ float rowmax(const f32x16& p0, const f32x16& p1) {
    float a = max3f(p0[0], p0[1], p1[0]), b = max3f(p0[2], p0[3], p1[1]); a = max3f(a, p1[2], p1[3]);
#pragma unroll
    for (int r = 4; r < 16; r += 4) { a = max3f(a, p0[r], p0[r + 1]); b = max3f(b, p0[r + 2], p0[r + 3]); a = max3f(a, p1[r], p1[r + 1]); b = max3f(b, p1[r + 2], p1[r + 3]); }
    const float m = max2f(a, b);
    auto rr = __builtin_amdgcn_permlane32_swap(__float_as_uint(m), __float_as_uint(m), false, false);
    return max2f(__uint_as_float(rr[0]), __uint_as_float(rr[1]));
}
__device__ __forceinline__ void pv(f32x16* o, int vb, bf16x8 pa0, bf16x8 pa1, bf16x8 pa2, bf16x8 pa3) {
#pragma unroll
    for (int d0 = 0; d0 < 2; ++d0) { s16x4 lo[4], hi[4];
#pragma unroll
        for (int ks = 0; ks < 4; ++ks) {
            asm volatile("ds_read_b64_tr_b16 %0,%1 offset:%c2" : "=&v"(lo[ks]) : "v"(vb), "i"(d0 * 4096 + ks * 1024) : "memory");
            asm volatile("ds_read_b64_tr_b16 %0,%1 offset:%c2" : "=&v"(hi[ks]) : "v"(vb), "i"(d0 * 4096 + ks * 1024 + 512) : "memory"); }
        asm volatile("s_waitcnt lgkmcnt(0)" ::: "memory"); SBAR();
#define PK(k) (bf16x8){lo[k][0], lo[k][1], lo[k][2], lo[k][3], hi[k][0], hi[k][1], hi[k][2], hi[k][3]}
        o[d0] = __builtin_amdgcn_mfma_f32_32x32x16_bf16(pa0, PK(0), o[d0], 0, 0, 0);
        o[d0] = __builtin_amdgcn_mfma_f32_32x32x16_bf16(pa1, PK(1), o[d0], 0, 0, 0);
        o[d0] = __builtin_amdgcn_mfma_f32_32x32x16_bf16(pa2, PK(2), o[d0], 0, 0, 0);
        o[d0] = __builtin_amdgcn_mfma_f32_32x32x16_bf16(pa3, PK(3), o[d0], 0, 0, 0);
#undef PK
    }
}

template <int THRL, bool DRY> __device__ __forceinline__ void attn_unit(int b, int h, int qb, const bf16* Q, const bf16* __restrict__ K, const bf16* __restrict__ V, const bf16* __restrict__ KL, const bf16* __restrict__ VL, bf16* O, const float* __restrict__ C2, char* shm) {
    int tid_ = threadIdx.x; asm volatile("" : "+v"(tid_));
    const int tid = tid_, lane = tid & 63, r32 = lane & 31, hi = lane >> 5; const int wid = __builtin_amdgcn_readfirstlane(tid >> 6);
    const long rowbase = (long)b * PP; const int q0 = 128 + qb * QB;
    const bf16* Qw = Q + (rowbase + q0 + wid * QBLK) * DM + h * D;
    const bf16* Kh = K + (rowbase + 64) * DM + h * D, *Vh = V + (rowbase + 64) * DM + h * D;
    const unsigned lds0 = (unsigned)(uintptr_t)shm;
    float* wsf = (float*)(shm + LDS_WS) + wid * 64;
    const int NT = 6 + 4 * qb, NTR = NT - 1;
    const lds_cptr shm3 = (lds_cptr)shm;
    const float* c2g = C2 + ((size_t)(b * 16 + h)) * PP + 64;
    { LAS float* c2w = (LAS float*)(shm3 + LDS_C2); LAS float* c2tw = (LAS float*)(shm3 + LDS_C2T);
      for (int i = tid; i < 64 * NT; i += 512) c2w[i] = (i < 64 * NTR) ? (c2g[i] - c2g[i | 63]) : 0.f;
      if (tid < NT) c2tw[tid] = (tid < NTR) ? c2g[64 * tid + 63] : 0.f; }
    const float c2q = c2g[q0 - 64 + wid * QBLK + r32];
    const LAS float* c2s = (const LAS float*)(shm3 + LDS_C2) + 4 * hi;
    const LAS float* c2t = (const LAS float*)(shm3 + LDS_C2T);
    const bf16* ksrc = Kh + (long)lane * DM + wid * 8;
    const bf16* vsrc = Vh + (long)(16 * (wid & 3) + (lane >> 2)) * DM + (wid >> 2) * 32 + (lane & 3) * 8;
    const unsigned kdst = lds0 + LDS_K + wid * 1024, vdst = lds0 + LDS_V + wid * 1024;
#define TCL(t) (((t) < NTR) ? (t) : (NTR - 1))
#define DMA_K(t, slot) glds16(ksrc + (long)TCL(t) * KVBLK * DM, (unsigned)__builtin_amdgcn_readfirstlane(kdst + (slot)))
#define DMA_V(t, slot) glds16(vsrc + (long)TCL(t) * KVBLK * DM, (unsigned)__builtin_amdgcn_readfirstlane(vdst + (slot)))
    const int vb0 = (int)(lds0 + LDS_V) + ((lane >> 4) & 1) * 32 + (lane & 3) * 8 + (4 * hi + ((lane & 15) >> 2)) * 64;
    const char* Kbase = shm + LDS_K; bf16x8 kf[8];
    const lds_cptr kp0 = shm3 + LDS_K + hi * 1024 + r32 * 16; const lds_cptr vp0 = shm3 + LDS_V + ((lane >> 4) & 1) * 32 + (lane & 3) * 8 + (4 * hi + ((lane & 15) >> 2)) * 64;
    glds16(KL + (long)(64 + lane) * DM + h * D + wid * 8, (unsigned)__builtin_amdgcn_readfirstlane(kdst));
    glds16(VL + (long)(64 + 16 * (wid & 3) + (lane >> 2)) * DM + h * D + (wid >> 2) * 32 + (lane & 3) * 8, (unsigned)__builtin_amdgcn_readfirstlane(vdst));
    DMA_K(1, SLOTB);
    bf16x8 qr[4];
#pragma unroll
    for (int d0 = 0; d0 < 4; ++d0) qr[d0] = *reinterpret_cast<const bf16x8*>(&Qw[(long)r32 * DM + d0 * 16 + hi * 8]);
    float l_reg = 0.f; f32x16 o[2]; o[0] = f32x16{}; o[1] = f32x16{}; const f32x16 negm = f32x16{}; float moff = 0.f, mq = 0.f;
    const int qrel = wid * QBLK + r32;
#define CMASK(P0, P1, t) do { int jb_ = (t) - (NT - 5); if (jb_ >= 0) cmask(P0, P1, jb_, qrel, hi); } while (0)
    bool resc = false;
#define EXD(P, OFF) do { _Pragma("unroll") for (int g_ = 0; g_ < 4; ++g_) { const f32x4 dk_ = *(const LAS f32x4*)(c2s + (OFF) + 8 * g_); \
      _Pragma("unroll") for (int i_ = 0; i_ < 4; ++i_) P[4 * g_ + i_] = __builtin_amdgcn_exp2f((P[4 * g_ + i_] - moff) - dk_[i_]); } } while (0)
#define START(P0, P1) do { const float rmr = rowmax(P0, P1); resc = false; \
    mq = rmr - c2t[0]; moff = rmr; \
    EXD(P0, 0); } while (0)
#define RESC() do { if (resc) { asm volatile("s_waitcnt lgkmcnt(0)" ::: "memory"); \
      _Pragma("unroll") for (int d_ = 0; d_ < 2; ++d_) _Pragma("unroll") for (int r = 0; r < 16; ++r) o[d_][r] *= wsf[crow(r, hi)]; } } while (0)
    f32x16 pA0, pA1, pB0, pB1;
    int sl_prev = 0, sl_cur = 0, sl_next = SLOTB;
#define ROT() do { sl_prev = sl_cur; sl_cur = sl_next; sl_next = (sl_next == (NSLOT - 1) * SLOTB) ? 0 : sl_next + SLOTB; } while (0)
    DMA_K(2, 2 * SLOTB);
    WAIT_BAR(3);
    qkt(pA0, pA1, Kbase, qr, negm, r32, hi); asm volatile("s_nop 15\n\ts_nop 7" : "+v"(pA0), "+v"(pA1)); CMASK(pA0, pA1, 0);
    START(pA0, pA1);
    EXD(pA1, 32);
    WAIT_BAR(0);
    DMA_K(3, 0); DMA_V(1, SLOTB);
    ROT();
    kload8(kf, kp0 + sl_cur);
    WAIT_BAR(2);
    s16x4 vlo[8], vhi[8]; u32x4 pw0, pw1, pw2, pw3;
#define PKW(P, B) cvtpk_s(P[B], P[B + 1])
#define PAF(k) __builtin_bit_cast(bf16x8, pw##k)
#define VFR(i) (bf16x8){vlo[i][0], vlo[i][1], vlo[i][2], vlo[i][3], vhi[i][0], vhi[i][1], vhi[i][2], vhi[i][3]}
#define PIN(x) asm volatile("" : "+v"(x))
#define MX3(a, b, c) __builtin_fmaxf(__builtin_fmaxf((a), (b)), (c))
#define GAPA(MF, A0, A1, A2, A3, W0, W1, PW) do { MF; sacc += A0; sacc += A1; sacc += A2; sacc += A3; PIN(sacc); W0; W1; PIN(PW); SBAR(); } while (0)
#define EX(v) __builtin_amdgcn_exp2f(v)
#define DKR(OFF) (*(const LAS f32x4*)(dkp_ + (OFF)))
#define GAPB(MF, X, B, DKC, DKN, OFFN) do { MF; DKN = DKR(OFFN); X[B] = EX((X[B] - moff) - DKC[0]); X[B + 1] = EX((X[B + 1] - moff) - DKC[1]); X[B + 2] = EX((X[B + 2] - moff) - DKC[2]); X[B + 3] = EX((X[B + 3] - moff) - DKC[3]); PIN(X); SBAR(); } while (0)
#define VRD(i) do { vlo[i] = vtr(vp_ + (((i) >> 2) * 4096 + ((i) & 3) * 1024)); vhi[i] = vtr(vp_ + (((i) >> 2) * 4096 + ((i) & 3) * 1024 + 512)); } while (0)
#define KRD(G, j) do { if (G) { kload2(kf, kp0 + sl_next, j); SBAR(); } } while (0)
#define STEP(C0, C1, P0, P1, t, GK, GV, GL) do { SBAR(); \
    const lds_cptr vp_ = vp0 + sl_prev; \
    VRD(0); SBAR(); float sacc = (P0[0] + P0[1]); \
    GAPA(C0 = __builtin_amdgcn_mfma_f32_32x32x16_bf16(kf[0], qr[0], negm, 0, 0, 0), P0[2], P0[3], P0[4], P0[5],     pw0[0] = PKW(P0, 0), pw0[1] = PKW(P0, 2), pw0); \
    VRD(4); SBAR(); GAPA(C1 = __builtin_amdgcn_mfma_f32_32x32x16_bf16(kf[1], qr[0], negm, 0, 0, 0), P0[6], P0[7], P0[8], P0[9],     pw0[2] = PKW(P0, 4), pw0[3] = PKW(P0, 6), pw0); \
    VRD(1); SBAR(); GAPA(C0 = __builtin_amdgcn_mfma_f32_32x32x16_bf16(kf[2], qr[1], C0, 0, 0, 0),   P0[10], P0[11], P0[12], P0[13], pw1[0] = PKW(P0, 8), pw1[1] = PKW(P0, 10), pw1); \
    VRD(5); SBAR(); GAPA(C1 = __builtin_amdgcn_mfma_f32_32x32x16_bf16(kf[3], qr[1], C1, 0, 0, 0),   P0[14], P0[15], P1[0], P1[1],   pw1[2] = PKW(P0, 12), pw1[3] = PKW(P0, 14), pw1); \
    VRD(2); SBAR(); GAPA(C0 = __builtin_amdgcn_mfma_f32_32x32x16_bf16(kf[4], qr[2], C0, 0, 0, 0),   P1[2], P1[3], P1[4], P1[5],     pw2[0] = PKW(P1, 0), pw2[1] = PKW(P1, 2), pw2); \
    VRD(6); SBAR(); GAPA(C1 = __builtin_amdgcn_mfma_f32_32x32x16_bf16(kf[5], qr[2], C1, 0, 0, 0),   P1[6], P1[7], P1[8], P1[9],     pw2[2] = PKW(P1, 4), pw2[3] = PKW(P1, 6), pw2); \
    VRD(3); SBAR(); GAPA(C0 = __builtin_amdgcn_mfma_f32_32x32x16_bf16(kf[6], qr[3], C0, 0, 0, 0),   P1[10], P1[11], P1[12], P1[13], pw3[0] = PKW(P1, 8), pw3[1] = PKW(P1, 10), pw3); \
    VRD(7); SBAR(); GAPA(C1 = __builtin_amdgcn_mfma_f32_32x32x16_bf16(kf[7], qr[3], C1, 0, 0, 0),   P1[14], P1[15], 0.f, 0.f,       pw3[2] = PKW(P1, 12), pw3[3] = PKW(P1, 14), pw3); \
    l_reg += sacc; \
    if (GK) { DMA_K((t) + 3, sl_cur); } if (GV) { DMA_V((t) + 1, sl_next); } \
    CMASK(C0, C1, t); \
    const LAS float* dkp_ = c2s + 64 * (t); f32x4 dkA_ = DKR(0), dkB_; \
    { float a = MX3(C0[0], C0[1], C1[0]), b = MX3(C0[2], C0[3], C1[1]); a = MX3(a, C1[2], C1[3]); \
      _Pragma("unroll") for (int r = 4; r < 16; r += 4) { a = MX3(a, C0[r], C0[r + 1]); b = MX3(b, C0[r + 2], C0[r + 3]); a = MX3(a, C1[r], C1[r + 1]); b = MX3(b, C1[r + 2], C1[r + 3]); } \
      float rm = __builtin_fmaxf(a, b); { auto rr = __builtin_amdgcn_permlane32_swap(__float_as_uint(rm), __float_as_uint(rm), false, false); rm = __builtin_fmaxf(__uint_as_float(rr[0]), __uint_as_float(rr[1])); } \
      moff = mq + c2t[t]; rm -= moff; \
      resc = false; \
      if (__builtin_expect(__any(rm > (float)THRL), 0)) { const float dl = __builtin_fmaxf(rm, 0.f); mq += dl; moff += dl; \
        const float f = __builtin_amdgcn_exp2f(-dl); l_reg *= f; if (hi == 0) wsf[r32] = f; resc = true; } } \
    SBAR(); \
    GAPB(o[0] = __builtin_amdgcn_mfma_f32_32x32x16_bf16(PAF(0), VFR(0), o[0], 0, 0, 0), C0, 0, dkA_, dkB_, 8); \
    GAPB(o[1] = __builtin_amdgcn_mfma_f32_32x32x16_bf16(PAF(0), VFR(4), o[1], 0, 0, 0), C0, 4, dkB_, dkA_, 16); \
    KRD(GL, 0); GAPB(o[0] = __builtin_amdgcn_mfma_f32_32x32x16_bf16(PAF(1), VFR(1), o[0], 0, 0, 0), C0, 8, dkA_, dkB_, 24); \
    KRD(GL, 1); GAPB(o[1] = __builtin_amdgcn_mfma_f32_32x32x16_bf16(PAF(1), VFR(5), o[1], 0, 0, 0), C0, 12, dkB_, dkA_, 32); \
    KRD(GL, 2); GAPB(o[0] = __builtin_amdgcn_mfma_f32_32x32x16_bf16(PAF(2), VFR(2), o[0], 0, 0, 0), C1, 0, dkA_, dkB_, 40); \
    KRD(GL, 3); GAPB(o[1] = __builtin_amdgcn_mfma_f32_32x32x16_bf16(PAF(2), VFR(6), o[1], 0, 0, 0), C1, 4, dkB_, dkA_, 48); \
    GAPB(o[0] = __builtin_amdgcn_mfma_f32_32x32x16_bf16(PAF(3), VFR(3), o[0], 0, 0, 0), C1, 8, dkA_, dkB_, 56); \
    GAPB(o[1] = __builtin_amdgcn_mfma_f32_32x32x16_bf16(PAF(3), VFR(7), o[1], 0, 0, 0), C1, 12, dkB_, dkA_, 56); \
    } while (0)
    int t = 1;
#undef CMASK
#define CMASK(P0, P1, t) do { } while (0)
    for (; t + 6 < NT; t += 2) {
        STEP(pB0, pB1, pA0, pA1, t, true, true, true);     WAIT_BAR(2); RESC(); ROT();
        STEP(pA0, pA1, pB0, pB1, t + 1, true, true, true); WAIT_BAR(2); RESC(); ROT();
    }
#undef CMASK
#define CMASK(P0, P1, t) do { int jb_ = (t) - (NT - 5); if (jb_ >= 0) cmask(P0, P1, jb_, qrel, hi); } while (0)
#define ENDW(tt) do { if ((tt) + 3 < NT) { WAIT_BAR(2); } else if ((tt) + 2 < NT) { WAIT_BAR(1); } else { WAIT_BAR(0); } } while (0)
    for (; t + 1 < NT; t += 2) {
        STEP(pB0, pB1, pA0, pA1, t, (t + 3 < NT), (t + 1 < NT), (t + 1 < NT));         ENDW(t);     RESC(); ROT();
        STEP(pA0, pA1, pB0, pB1, t + 1, (t + 4 < NT), (t + 2 < NT), (t + 2 < NT));     ENDW(t + 1); RESC(); ROT();
    }
    STEP(pB0, pB1, pA0, pA1, NT - 1, false, false, false); RESC();
    { float sacc = pB0[0] + pB0[1]; _Pragma("unroll") for (int r = 2; r < 16; ++r) sacc += pB0[r]; _Pragma("unroll") for (int r = 0; r < 16; ++r) sacc += pB1[r]; l_reg += sacc;
      pw0 = (u32x4){PKW(pB0, 0), PKW(pB0, 2), PKW(pB0, 4), PKW(pB0, 6)}; pw1 = (u32x4){PKW(pB0, 8), PKW(pB0, 10), PKW(pB0, 12), PKW(pB0, 14)}; pw2 = (u32x4){PKW(pB1, 0), PKW(pB1, 2), PKW(pB1, 4), PKW(pB1, 6)}; pw3 = (u32x4){PKW(pB1, 8), PKW(pB1, 10), PKW(pB1, 12), PKW(pB1, 14)};
      SBAR(); pv(o, vb0 + sl_cur, PAF(0), PAF(1), PAF(2), PAF(3)); }
#undef PKW
#undef PAF
#undef VFR
#undef PIN
#undef MX3
#undef GAPA
#undef GAPB
#undef EX
#undef DKR
#undef VRD
#undef KRD
#undef STEP
#undef ENDW
    { auto rr = __builtin_amdgcn_permlane32_swap(__float_as_uint(l_reg), __float_as_uint(l_reg), false, false); l_reg = __uint_as_float(rr[0]) + __uint_as_float(rr[1]); }
    if (hi == 0) wsf[32 + r32] = l_reg; asm volatile("s_waitcnt lgkmcnt(0)" ::: "memory");
    float rli[16];
#pragma unroll
    for (int r = 0; r < 16; ++r) rli[r] = __builtin_amdgcn_rcpf(wsf[32 + crow(r, hi)]);
    bf16* Ow = O + (rowbase + q0 + wid * QBLK) * DM + h * D;
    { bf16* stg = (bf16*)(shm + LDS_OST) + wid * 2048;
#pragma unroll
      for (int r = 0; r < 16; ++r) { const int orow = crow(r, hi);
#pragma unroll
        for (int d0 = 0; d0 < 2; ++d0) stg[orow * 64 + d0 * 32 + r32] = __float2bfloat16(o[d0][r] * rli[r]); }
      asm volatile("s_waitcnt lgkmcnt(0)" ::: "memory");
#pragma unroll
      for (int i = 0; i < 4; ++i) { const int row = i * 8 + (lane >> 3), ch = lane & 7; const u32x4 v = *(const u32x4*)(stg + row * 64 + ch * 8); if (!DRY || v.x == 0x12345679u) *(u32x4*)(Ow + (long)row * DM + ch * 8) = v; } }
    asm volatile("s_waitcnt lgkmcnt(0)\n\ts_barrier" ::: "memory");
#undef DMA_K
#undef DMA_V
#undef TCL
#undef CMASK
#undef EXD
#undef START
#undef RESC
#undef ROT
}
#undef SBAR
#undef WAIT_BAR
}

constexpr int RING_BYTES = 131072;
constexpr int LDS_BYTES = 147456;

__device__ __forceinline__ void tr_item(const float* W, int ldw, int K, int k0, int nvalid, const float* gain, bf16_t* dst, LAS float* scr, int lane) {
    float tv[32];
#pragma unroll
    for (int i = 0; i < 32; ++i) { const int kk = 2 * i + (lane >> 5), c = lane & 31; tv[i] = (c < nvalid) ? W[(size_t)(k0 + kk) * ldw + c] : 0.f; }
#pragma unroll
    for (int i = 0; i < 32; ++i) { const int kk = 2 * i + (lane >> 5), c = lane & 31; float v = tv[i]; if (gain) v *= gain[k0 + kk]; scr[kk * 33 + c] = v; }
    LDS_WAIT(); asm volatile("" ::: "memory");
    const int c8 = lane & 7;
#pragma unroll
    for (int j = 0; j < 4; ++j) { const int n = (lane >> 3) + 8 * j; const LAS float* s = scr + (8 * c8) * 33 + n;
        u32x4 o; o.x = cvt_pk_bf16(s[0 * 33], s[1 * 33]); o.y = cvt_pk_bf16(s[2 * 33], s[3 * 33]); o.z = cvt_pk_bf16(s[4 * 33], s[5 * 33]); o.w = cvt_pk_bf16(s[6 * 33], s[7 * 33]);
        *(u32x4*)(dst + (size_t)n * K + k0 + 8 * c8) = o; }
    LDS_WAIT(); asm volatile("" ::: "memory");
}
enum MapMode { MAP_ID = 0, MAP_SWA, MAP_SWB, MAP_H64, MAP_ROT };
__device__ __forceinline__ int map_row(int mode, int nb) {
    const int c = 32 * nb;
    switch (mode) {
        case MAP_SWA: return 256 * (c >> 7) + (c & 127);
        case MAP_SWB: return 256 * (c >> 7) + 128 + (c & 127);
        case MAP_H64: { const int tl = c >> 8, ob = (c & 255) >> 5; return 256 * tl + 128 * (ob & 1) + 32 * (ob >> 1); }
        case MAP_ROT: { const int tl = c >> 8, ob = (c & 255) >> 5; return 256 * tl + 128 * ((ob >> 1) & 1) + 64 * (ob >> 2) + 32 * (ob & 1); }
        default: return c;
    }
}
struct Seg { const float* W; int ldw, K, ncols; const float* gain; size_t dst; int dstrow, mode; };
__device__ __forceinline__ Seg get_seg(const Params& p, int s) {
    switch (s) {
        case 0: return Seg{p.w1i, 2 * DFF, 1024, DFF, p.n1, WS_W1A, 0, MAP_SWA};
        case 1: return Seg{p.w1i + DFF, 2 * DFF, 1024, DFF, p.n1, WS_W1A, 0, MAP_SWB};
        case 2: return Seg{p.w1o, 1024, DFF, 1024, nullptr, WS_W1B, 0, MAP_ID};
        case 3: return Seg{p.win + 0, NINC, 1024, 1024, p.nm, WS_WIN, WIN_FOX, MAP_H64};
        case 4: return Seg{p.win + 1024, NINC, 1024, 1024, p.nm, WS_WIN, WIN_FOX + 1024, MAP_H64};
        case 5: return Seg{p.win + 2048, NINC, 1024, 1024, p.nm, WS_WIN, WIN_FOX + 2048, MAP_ID};
        case 6: return Seg{p.win + 3072, NINC, 1024, 16, p.nm, WS_WIN, WIN_RET + 3072, MAP_ID};
        case 7: return Seg{p.win + 3088, NINC, 1024, 512, p.nm, WS_WIN, WIN_RET + 0, MAP_ROT};
        case 8: return Seg{p.win + 3600, NINC, 1024, 512, p.nm, WS_WIN, WIN_RET + 512, MAP_ROT};
        case 9: return Seg{p.win + 4112, NINC, 1024, 1024, p.nm, WS_WIN, WIN_RET + 1024, MAP_ID};
        case 10: return Seg{p.win + 5136, NINC, 1024, 1024, p.nm, WS_WIN, WIN_RET + 2048, MAP_ID};
        case 11: return Seg{p.win + 6160, NINC, 1024, 1024, p.nm, WS_WIN, WIN_GA, MAP_ID};
        case 12: return Seg{p.win + 7184, NINC, 1024, 1024, p.nm, WS_WIN, WIN_GB, MAP_ID};
        case 13: return Seg{p.wof, 1024, 1024, 1024, nullptr, WS_WOF, 0, MAP_ID};
        case 14: return Seg{p.wor, 1024, 1024, 1024, nullptr, WS_WOR, 0, MAP_ID};
        case 15: return Seg{p.wout, 1024, 1024, 1024, nullptr, WS_WOUT, 0, MAP_ID};
        case 16: return Seg{p.w2i, 2 * DFF, 1024, DFF, p.n2, WS_W2A, 0, MAP_SWA};
        case 17: return Seg{p.w2i + DFF, 2 * DFF, 1024, DFF, p.n2, WS_W2A, 0, MAP_SWB};
        default: return Seg{p.w2o, 1024, DFF, 1024, nullptr, WS_W2B, 0, MAP_ID};
    }
}
__device__ __forceinline__ int seg_items(int s) {
    switch (s) {
        case 0: case 1: case 16: case 17: return 16 * 88;
        case 2: case 18: return 44 * 32;
        case 6: return 16;
        case 7: case 8: return 16 * 16;
        default: return 16 * 32;
    }
}
__device__ __forceinline__ void convert_range(const Params& p, LAS float* scr, int s_lo, int s_hi, int worker, int nworkers, int lane) {
    int total = 0;
#pragma unroll 1
    for (int s = s_lo; s <= s_hi; ++s) total += seg_items(s);
#pragma unroll 1
    for (int it = worker; it < total; it += nworkers) {
        int r = it, s = s_lo;
        while (r >= seg_items(s)) { r -= seg_items(s); ++s; }
        const Seg sg = get_seg(p, s);
        const int nblk = (sg.ncols + 31) / 32, kb = r / nblk, nb = r % nblk;
        const int nvalid = sg.ncols - 32 * nb < 32 ? sg.ncols - 32 * nb : 32;
        bf16_t* dst = (bf16_t*)(p.ws + sg.dst) + (size_t)(sg.dstrow + map_row(sg.mode, nb)) * sg.K;
        tr_item(sg.W + 32 * nb, sg.ldw, sg.K, 64 * kb, nvalid, sg.gain, dst, scr, lane);
    }
}
__device__ __forceinline__ void p0_prologue(const KP kp_, LAS unsigned char* lds, int vcu, int G, int tid, int wid, int lane) {
    const Params p = ldp(kp_);
    LAS float* scr = (LAS float*)(lds + wid * 16384);
    const int gw = vcu * 8 + wid, NGW = G * 8;
    convert_range(p, scr, 0, 1, gw, NGW, lane);
    { u32x4* z = (u32x4*)((bf16_t*)(p.ws + WS_WIN) + (size_t)(WIN_RET + 3072 + 32) * 1024); const int nz = 224 * 1024 * 2 / 16;
      for (int i = (vcu * 512 + tid); i < nz; i += G * 512) z[i] = (u32x4){0u, 0u, 0u, 0u}; }
    { bf16_t* XB = (bf16_t*)(p.ws + WS_XB); float* S0 = (float*)(p.ws + WS_SSQ0);
      for (int row0 = gw; row0 < MP; row0 += 2 * NGW) {
        f32x4 v[2][4]; float s[2];
#pragma unroll
        for (int h = 0; h < 2; ++h) { const int row = row0 + h * NGW; const int b = row / PP, pidx = row - b * PP;
#pragma unroll
            for (int j = 0; j < 4; ++j) { v[h][j] = (f32x4){0.f, 0.f, 0.f, 0.f};
                if (row < MP) { if (pidx >= 128) v[h][j] = *((const f32x4*)(p.x + ((size_t)(b * SEQ + pidx - 128)) * DM) + lane + 64 * j);
                    else if (pidx >= 112) v[h][j] = *((const f32x4*)(p.meta + (size_t)(pidx - 112) * DM) + lane + 64 * j); } } }
#pragma unroll
        for (int h = 0; h < 2; ++h) { s[h] = 0.f;
#pragma unroll
            for (int j = 0; j < 4; ++j) s[h] += (v[h][j][0] * v[h][j][0] + v[h][j][1] * v[h][j][1]) + (v[h][j][2] * v[h][j][2] + v[h][j][3] * v[h][j][3]);
            s[h] = wave_sum(s[h]); }
#pragma unroll
        for (int h = 0; h < 2; ++h) { const int row = row0 + h * NGW; if (row < MP) {
            u32x2* o8 = (u32x2*)(XB + (size_t)row * DM) + lane;
#pragma unroll
            for (int j = 0; j < 4; ++j) o8[64 * j] = pack4(v[h][j]);
            if (lane < 16) S0[(size_t)row * 16 + lane] = (lane == 0) ? s[h] : 0.f; } } } }
    { float* S1 = (float*)(p.ws + WS_SSQ1); for (int i = vcu * 512 + tid; i < NB * 2048; i += G * 512) S1[(size_t)(i >> 11) * PP * 16 + (i & 2047)] = 0.f; }
    { float* COS = (float*)(p.ws + WS_COS); float* SIN = (float*)(p.ws + WS_SIN);
      for (int i = vcu * 512 + tid; i < PP * 64; i += G * 512) { const int pidx = i >> 6, fi = i & 63;
        const float inv = exp2f(-(float)fi * (13.287712379549449f / 64.0f));
        const float ang = (float)(pidx - 112) * inv;
        const double a = (double)ang; const double kq = rint(a * 0.15915494309189535); const float red = (float)(a - kq * 6.283185307179586);
        COS[i] = __cosf(red); SIN[i] = __sinf(red); } }
}

__device__ __forceinline__ void thin_g2(const KP kp_, LAS unsigned char* lds, int bx, int wid, int lane) {
    if (bx >= 64) return;
    const Params p = ldp(kp_);
    const int l15 = lane & 15, g = lane >> 4, tile = bx, n0 = tile * 16;
    const bf16_t* wp = (const bf16_t*)(p.ws + WS_W1B) + (size_t)(n0 + l15) * DFF + 352 * wid + 8 * g;
    const bf16_t* hp = (const bf16_t*)(p.ws + WS_HID) + (size_t)(112 + l15) * DFF + 352 * wid + 8 * g;
    f32x4 acc = (f32x4){0.f, 0.f, 0.f, 0.f};
    bf16x8 a[11], b[11];
#pragma unroll
    for (int i = 0; i < 11; ++i) { a[i] = *(const bf16x8*)(wp + 32 * i); b[i] = *(const bf16x8*)(hp + 32 * i); }
#pragma unroll
    for (int i = 0; i < 11; ++i) acc = __builtin_amdgcn_mfma_f32_16x16x32_bf16(a[i], b[i], acc, 0, 0, 0);
    LAS f32x4* part = (LAS f32x4*)lds;
    part[wid * 64 + lane] = acc;
    __syncthreads();
    if (wid == 0) {
#pragma unroll
        for (int w = 1; w < 8; ++w) acc += part[w * 64 + lane];
        const f32x4 base = *(const f32x4*)(p.meta + (size_t)l15 * DM + n0 + 4 * g);
        const f32x4 h = base + acc * 0.5f;
        float ss = (h[0] * h[0] + h[1] * h[1]) + (h[2] * h[2] + h[3] * h[3]);
        ss += __shfl_xor(ss, 16); ss += __shfl_xor(ss, 32);
        bf16_t* HB = (bf16_t*)(p.ws + WS_XB); float* S1 = (float*)(p.ws + WS_SSQ1);
#pragma unroll
        for (int bb = 0; bb < NB; ++bb) { const size_t row = (size_t)bb * PP + 112 + l15;
            *(u32x2*)(HB + row * DM + n0 + 4 * g) = pack4(h);
            if (g == 0) atomicAdd(S1 + row * 16 + (tile & 15), ss); }
    }
    __syncthreads();
}

__device__ __forceinline__ float lg2gamma(int hd) { return log2f(1.0f - exp2f(-5.0f - (float)hd)); }
__device__ __forceinline__ void ret_kv_phase(const KP kp_, int vcu, int G, int wid, int lane) {
    const Params p = ldp(kp_);
    const bf16_t* KT = (const bf16_t*)(p.ws + WS_KT); const bf16_t* VT = (const bf16_t*)(p.ws + WS_VT); bf16_t* KVR = (bf16_t*)(p.ws + WS_KVR);
    const int l15 = lane & 15, g = lane >> 4;
#pragma unroll 1
    for (int u = vcu; u < 16 * 32; u += G) {
        const int bh = u >> 5, c = u & 31, hd = bh & 3; const float lg = lg2gamma(hd);
        const int bhs = (c == 0) ? hd : bh;
        f32x4 acc[2][8];
#pragma unroll
        for (int a = 0; a < 2; ++a)
#pragma unroll
            for (int b = 0; b < 8; ++b) acc[a][b] = (f32x4){0.f, 0.f, 0.f, 0.f};
#pragma unroll 1
        for (int s = 0; s < 4; ++s) {
            const int ml = 32 * s + 8 * g, m0 = 128 * c + ml;
            bf16x8 a[2]; u32x4 raw[2]; bf16x8 bfr[8];
#pragma unroll
            for (int ti = 0; ti < 2; ++ti) raw[ti] = *(const u32x4*)(VT + ((size_t)(bhs * 256 + 32 * wid + 16 * ti + l15)) * PP + m0);
#pragma unroll
            for (int tj = 0; tj < 8; ++tj) bfr[tj] = *(const bf16x8*)(KT + ((size_t)(bhs * 128 + 16 * tj + l15)) * PP + m0);
            asm volatile("" ::: "memory");
            float z[8];
#pragma unroll
            for (int j = 0; j < 8; ++j) z[j] = exp2f(lg * (float)(127 - (ml + j)));
#pragma unroll
            for (int ti = 0; ti < 2; ++ti) { u32x4 w; w.x = cvt_pk_bf16(bf_lo(raw[ti].x) * z[0], bf_hi(raw[ti].x) * z[1]); w.y = cvt_pk_bf16(bf_lo(raw[ti].y) * z[2], bf_hi(raw[ti].y) * z[3]);
                w.z = cvt_pk_bf16(bf_lo(raw[ti].z) * z[4], bf_hi(raw[ti].z) * z[5]); w.w = cvt_pk_bf16(bf_lo(raw[ti].w) * z[6], bf_hi(raw[ti].w) * z[7]);
                a[ti] = __builtin_bit_cast(bf16x8, w); }
#pragma unroll
            for (int tj = 0; tj < 8; ++tj) {
                acc[0][tj] = __builtin_amdgcn_mfma_f32_16x16x32_bf16(bfr[tj], a[0], acc[0][tj], 0, 0, 0);
                acc[1][tj] = __builtin_amdgcn_mfma_f32_16x16x32_bf16(bfr[tj], a[1], acc[1][tj], 0, 0, 0); }
        }
        bf16_t* o = KVR + ((size_t)(bh * 33 + c)) * 32768;
#pragma unroll
        for (int ti = 0; ti < 2; ++ti)
#pragma unroll
            for (int tj = 0; tj < 8; ++tj) *(u32x2*)(o + (size_t)(32 * wid + 16 * ti + l15) * 128 + 16 * tj + 4 * g) = pack4(acc[ti][tj]);
    }
}
__device__ __forceinline__ void cumsum_phase(const KP kp_, LAS unsigned char* lds, int vcu, int G, int wid, int lane) {
    const Params p = ldp(kp_);
    const float* LF = (const float*)(p.ws + WS_LOGF);
    LAS float* tot = (LAS float*)lds;
#pragma unroll 1
    for (int sq = vcu; sq < 64; sq += G) {
        const float* base = LF + (size_t)sq * PP; const float* base0 = LF + (size_t)(sq & 15) * PP; float* outp = (float*)(p.ws + WS_C2) + (size_t)sq * PP;
        const int cs = (wid * 66) >> 3, ce = ((wid + 1) * 66) >> 3;
        float inc[9]; float carry = 0.f;
#pragma unroll
        for (int k = 0; k < 9; ++k) { const int i = cs + k; float v = 0.f;
            if (i < ce) v = (i < 2) ? base0[64 * i + lane] : base[64 * i + lane];
            inc[k] = v; }
#pragma unroll
        for (int k = 0; k < 9; ++k) { float x = inc[k];
#pragma unroll
            for (int o = 1; o < 64; o <<= 1) { const float t = __shfl_up(x, o); if (lane >= o) x += t; }
            inc[k] = carry + x; carry += __shfl(x, 63); }
        if (lane == 0) tot[wid] = carry;
        __syncthreads();
        float pre = 0.f;
#pragma unroll
        for (int w = 0; w < 8; ++w) { const float t = tot[w]; if (w < wid) pre += t; }
#pragma unroll
        for (int k = 0; k < 9; ++k) { const int i = cs + k; if (i < ce) { const int pidx = 64 * i + lane; outp[pidx] = (pidx < 112) ? INFINITY : pre + inc[k]; } }
        __syncthreads();
    }
}
template <bool DRY> __device__ __forceinline__ void ret_scan_phase(const KP kp_, int G, int tid) {
    const Params p = ldp(kp_);
    bf16_t* KVR = (bf16_t*)(p.ws + WS_KVR);
#pragma unroll 1
    for (int it = blockIdx.x * 512 + tid; it < 131072; it += G * 512) {
        const int bh = it >> 13, off = (it & 8191) * 4, hd = bh & 3;
        const float Gm = exp2f(128.0f * lg2gamma(hd));
        u32x2* base = (u32x2*)(KVR + (size_t)bh * 33 * 32768 + off);
        u32x2 v[33];
#pragma unroll
        for (int c = 0; c < 32; ++c) v[c] = base[(size_t)c * 8192];
        v[32] = (u32x2){0u, 0u};
        f32x4 R = (f32x4){0.f, 0.f, 0.f, 0.f};
#pragma unroll
        for (int c = 0; c < 33; ++c) { const u32x2 rw = pack4(R); if (!DRY || rw.x == 0x12345679u) base[(size_t)c * 8192] = rw;
            R[0] = R[0] * Gm + bf_lo(v[c].x); R[1] = R[1] * Gm + bf_hi(v[c].x); R[2] = R[2] * Gm + bf_lo(v[c].y); R[3] = R[3] * Gm + bf_hi(v[c].y); }
    }
}
template <bool DRY> __device__ __forceinline__ void ret_out_phase(const KP kp_, LAS unsigned char* lds, int vcu, int G, int tid, int wid, int lane) {
    const Params p = ldp(kp_);
    const bf16_t* RQ = (const bf16_t*)(p.ws + WS_RQ); const bf16_t* RK = (const bf16_t*)(p.ws + WS_RK); const bf16_t* VT = (const bf16_t*)(p.ws + WS_VT);
    const bf16_t* KVR = (const bf16_t*)(p.ws + WS_KVR); bf16_t* YB = (bf16_t*)(p.ws + WS_SRG);
    const int l15 = lane & 15, g = lane >> 4;
    constexpr int PITCH = 272, VOFF = 256 * PITCH;
#pragma unroll 1
    for (int u = vcu; u < 512; u += G) {
        const int bh = u >> 5, c = (u & 31) + 1, b = bh >> 2, hd = bh & 3; const float lg = lg2gamma(hd);
        const int tw = (wid < 4) ? wid : 11 - wid;
        const int nl = 16 * tw + l15;
        const size_t rowq = (size_t)b * PP + 128 * c + nl;
        { const u32x4* rsrc = (const u32x4*)(KVR + ((size_t)(bh * 33 + c)) * 32768);
          u32x4 rr[8], vv[8];
#pragma unroll
          for (int i = 0; i < 8; ++i) { const int q = tid + 512 * i; rr[i] = rsrc[q];
              vv[i] = *(const u32x4*)(VT + ((size_t)(bh * 256 + (q >> 4))) * PP + 128 * c + (q & 15) * 8); }
#pragma unroll
          for (int i = 0; i < 8; ++i) { const int q = tid + 512 * i; const int off = (q >> 4) * PITCH + (q & 15) * 16;
              *(LAS u32x4*)(lds + off) = rr[i]; *(LAS u32x4*)(lds + VOFF + off) = vv[i]; } }
        bf16x8 qf[4];
#pragma unroll
        for (int s = 0; s < 4; ++s) qf[s] = *(const bf16x8*)(RQ + rowq * 512 + hd * 128 + 32 * s + 8 * g);
        __syncthreads();
        f32x4 acc[16];
#pragma unroll
        for (int ti = 0; ti < 16; ++ti) acc[ti] = (f32x4){0.f, 0.f, 0.f, 0.f};
        const LAS unsigned char* rbase = lds + l15 * PITCH + 16 * g;
#pragma unroll
        for (int s = 0; s < 4; ++s)
#pragma unroll
            for (int ti = 0; ti < 16; ++ti) { const bf16x8 a = *(const LAS bf16x8*)(rbase + 16 * ti * PITCH + 64 * s);
                acc[ti] = __builtin_amdgcn_mfma_f32_16x16x32_bf16(a, qf[s], acc[ti], 0, 0, 0); }
        const float xi = exp2f(lg * (float)(nl + 1));
#pragma unroll
        for (int ti = 0; ti < 16; ++ti) acc[ti] = acc[ti] * xi;
        const int nmb = (tw >> 1) + 1;
        const bf16_t* kp = RK + ((size_t)b * PP + 128 * c + l15) * 512 + hd * 128 + 8 * g;
        bf16x8 k0[4], k1[4], kn0[4], kn1[4];
#pragma unroll
        for (int s = 0; s < 4; ++s) { k0[s] = *(const bf16x8*)(kp + 32 * s); k1[s] = *(const bf16x8*)(kp + 16 * 512 + 32 * s); }
#pragma unroll 1
        for (int mb = 0; mb < nmb; ++mb) {
            f32x4 t0 = (f32x4){0.f, 0.f, 0.f, 0.f}, t1 = t0;
            { const bf16_t* kq = kp + (size_t)(mb + 1 < nmb ? mb + 1 : mb) * 32 * 512;
#pragma unroll
              for (int s = 0; s < 4; ++s) { kn0[s] = *(const bf16x8*)(kq + 32 * s); kn1[s] = *(const bf16x8*)(kq + 16 * 512 + 32 * s); } }
#pragma unroll
            for (int s = 0; s < 4; ++s) { t0 = __builtin_amdgcn_mfma_f32_16x16x32_bf16(k0[s], qf[s], t0, 0, 0, 0); t1 = __builtin_amdgcn_mfma_f32_16x16x32_bf16(k1[s], qf[s], t1, 0, 0, 0); }
#pragma unroll
            for (int s = 0; s < 4; ++s) { k0[s] = kn0[s]; k1[s] = kn1[s]; }
#pragma unroll
            for (int r = 0; r < 4; ++r) { const int d0 = nl - (32 * mb + 4 * g + r), d1 = d0 - 16;
                t0[r] = (d0 >= 0) ? t0[r] * exp2f(lg * (float)d0) : 0.f; t1[r] = (d1 >= 0) ? t1[r] * exp2f(lg * (float)d1) : 0.f; }
            const u32x2 s0 = pack4(t0), s1 = pack4(t1);
            const bf16x8 sb = __builtin_bit_cast(bf16x8, ((u32x4){s0.x, s0.y, s1.x, s1.y}));
            const LAS unsigned char* vbase = lds + VOFF + l15 * PITCH + 64 * mb + 8 * g;
#pragma unroll
            for (int ti = 0; ti < 16; ++ti) { const u32x2 lo = *(const LAS u32x2*)(vbase + 16 * ti * PITCH), hi2 = *(const LAS u32x2*)(vbase + 16 * ti * PITCH + 32);
                const bf16x8 a = __builtin_bit_cast(bf16x8, ((u32x4){lo.x, lo.y, hi2.x, hi2.y}));
                acc[ti] = __builtin_amdgcn_mfma_f32_16x16x32_bf16(a, sb, acc[ti], 0, 0, 0); }
        }
        float s = 0.f;
#pragma unroll
        for (int ti = 0; ti < 16; ++ti) s += (acc[ti][0] + acc[ti][1]) + (acc[ti][2] + acc[ti][3]);
        s += __shfl_xor(s, 16); s += __shfl_xor(s, 32);
        const float mean = s * (1.0f / 256.0f); float q = 0.f;
#pragma unroll
        for (int ti = 0; ti < 16; ++ti) { const f32x4 d = acc[ti] - mean; q += (d[0] * d[0] + d[1] * d[1]) + (d[2] * d[2] + d[3] * d[3]); }
        q += __shfl_xor(q, 16); q += __shfl_xor(q, 32);
        const float rstd = rsqrtf(q * (1.0f / 256.0f) + 1e-5f);
#pragma unroll
        for (int ti = 0; ti < 16; ++ti) { const int e0 = 16 * ti + 4 * g;
            const f32x4 gn = *(const f32x4*)(p.rgn + hd * 256 + e0);
            bf16_t* yp = YB + rowq * DM + hd * 256 + e0; const u32x2 sg = *(const u32x2*)yp;
            f32x4 o = (acc[ti] - mean) * rstd * gn; o[0] *= bf_lo(sg.x); o[1] *= bf_hi(sg.x); o[2] *= bf_lo(sg.y); o[3] *= bf_hi(sg.y);
            const u32x2 ow = pack4(o); if (!DRY || ow.x == 0x12345679u) *(u32x2*)yp = ow; }
        __syncthreads();
    }
}

#define XB_TMO      128
#define XB_XCNT(j)  (256  + 64 * (j))
#define XB_XSUB(j)  (1280 + 64 * (j))
#define XB_XGEN(j)  (2304 + 64 * (j))
#define XB_TOP      3328
#define XB_TOPGEN   3392
#define XCD_BAR_WORDS 3456
#define XB_SPIN_CAP (1u << 20)
constexpr size_t WS_BAR = 65536;
constexpr int LDS_MISC = 140000;
__device__ __forceinline__ unsigned xb_ld(unsigned* p)              { return __hip_atomic_load(p, __ATOMIC_RELAXED, __HIP_MEMORY_SCOPE_AGENT); }
__device__ __forceinline__ unsigned xb_add(unsigned* p, unsigned v) { return __hip_atomic_fetch_add(p, v, __ATOMIC_RELAXED, __HIP_MEMORY_SCOPE_AGENT); }
__device__ __forceinline__ unsigned xb_xcc_id() { return (unsigned)__builtin_amdgcn_s_getreg((3 << 11) | 20) & 0xFu; }
#define XB_SPIN(cond, bar) do { unsigned _sp = 0; while (cond) { __builtin_amdgcn_s_sleep(1); \
    if ((++_sp & 255u) == 0u) { if (xb_ld(&(bar)[XB_TMO])) break; if (_sp > XB_SPIN_CAP) { atomicAdd(&(bar)[XB_TMO], 1u); break; } } } } while (0)
__device__ __forceinline__ void xcd_barrier_complete(unsigned* bar, unsigned x, unsigned& nloc, unsigned& nx) {
    const unsigned G = gridDim.x * gridDim.y * gridDim.z;
    unsigned sum, cnt, mine, sp = 0u;
    for (;;) {
        sum = 0u; cnt = 0u; mine = 0u;
#pragma unroll
        for (unsigned j = 0; j < 16; ++j) { const unsigned c = xb_ld(&bar[XB_XCNT(j)]); sum += c; cnt += (c > 0u) ? 1u : 0u; mine = (j == x) ? c : mine; }
        if (sum == G) break;
        __builtin_amdgcn_s_sleep(1);
        if ((++sp & 255u) == 0u) { if (xb_ld(&bar[XB_TMO])) break; if (sp > XB_SPIN_CAP) { atomicAdd(&bar[XB_TMO], 1u); break; } }
    }
    nloc = mine > 0u ? mine : 1u; nx = cnt > 0u ? cnt : 1u;
}
__device__ __forceinline__ void xcd_barrier(unsigned* bar, volatile LAS unsigned* st) {
    asm volatile("s_waitcnt vmcnt(0)" ::: "memory");
    __syncthreads();
    if (threadIdx.x == 0) {
        const unsigned x = xb_xcc_id();
        __builtin_amdgcn_s_waitcnt(0);
        unsigned nloc = st[0], nx = st[1];
        if (nloc == 0u) { xcd_barrier_complete(bar, x, nloc, nx); st[0] = nloc; st[1] = nx; }
        const unsigned old = xb_add(&bar[XB_XSUB(x)], 1u);
        const unsigned gen = old / nloc;
        if (old + 1u == (gen + 1u) * nloc) {
            __builtin_amdgcn_fence(__ATOMIC_RELEASE, "agent");
            asm volatile("s_waitcnt vmcnt(0)" ::: "memory");
            const unsigned og = xb_add(&bar[XB_TOP], 1u);
            const unsigned tg = og / nx;
            if (og + 1u == (tg + 1u) * nx) xb_add(&bar[XB_TOPGEN], 1u);
            else XB_SPIN(xb_ld(&bar[XB_TOPGEN]) == tg, bar);
            __builtin_amdgcn_fence(__ATOMIC_ACQUIRE, "agent");
            xb_add(&bar[XB_XGEN(x)], 1u);
            asm volatile("s_waitcnt vmcnt(0)" ::: "memory");
        } else {
            XB_SPIN(xb_ld(&bar[XB_XGEN(x)]) == gen, bar);
            __builtin_amdgcn_fence(__ATOMIC_ACQUIRE, "agent");
            asm volatile("s_waitcnt vmcnt(0)" ::: "memory");
        }
    }
    __syncthreads();
}

extern __shared__ __attribute__((aligned(16))) unsigned char lds_raw[];
template <bool DRY> __device__ __forceinline__ void run_phase(const int ph) {
        const KP kp = kparams();
        int tid = threadIdx.x; asm volatile("" : "+v"(tid));
        int G = gridDim.x, bx = blockIdx.x; asm volatile("" : "+s"(G), "+s"(bx));
        LAS unsigned char* lds = (LAS unsigned char*)lds_raw;
        const int lane = tid & 63, wid = __builtin_amdgcn_readfirstlane(tid >> 6);
        const int vcu = (G % 8 == 0) ? (bx % 8) * (G / 8) + bx / 8 : bx;
        int gp = -1;
        switch (ph) {
            case 1: gp = pg8::GP_G1; break;
            case 2: gp = pg8::GP_G2; break;
            case 3: gp = pg8::GP_G3R; break;
            case 7: gp = pg8::GP_G3F; break;
            case 9: gp = pg8::GP_MIX; break;
            case 10: gp = pg8::GP_OUT; break;
            case 11: gp = pg8::GP_F2A; break;
            case 12: gp = pg8::GP_F2B; break;
            default: break;
        }
        if (gp >= 0) {
#ifndef NO_GEMM
            pg8::Epi E;
            pg8::Sched S; S.init(gp, G, bx);
            pg8::gemm_phase(lds, S, E);
            if (gp == pg8::GP_G2 && !DRY) thin_g2(kp, lds, bx, wid, lane);
            if (G == 256 && !DRY) {
                if (gp == pg8::GP_G1 && bx >= 172) { const Params p = ldp(kp); convert_range(p, (LAS float*)(lds + wid * 16384), 2, 10, (bx - 172) * 8 + wid, 84 * 8, lane); }
                if (gp == pg8::GP_G3R && bx >= 79) { const Params p = ldp(kp); convert_range(p, (LAS float*)(lds + wid * 16384), 11, 18, (bx - 79) * 8 + wid, 177 * 8, lane); }
            } else if (!DRY) {
                const Params p = ldp(kp);
                if (gp == pg8::GP_G1) convert_range(p, (LAS float*)(lds + wid * 16384), 2, 10, vcu * 8 + wid, G * 8, lane);
                if (gp == pg8::GP_G3R) convert_range(p, (LAS float*)(lds + wid * 16384), 11, 18, vcu * 8 + wid, G * 8, lane);
            }
#endif
        } else if (ph == 0) {
#ifndef NO_P0
            p0_prologue(kp, lds, vcu, G, tid, wid, lane);
#endif
        } else if (ph == 4) {
#ifndef NO_R1
            if (!DRY) cumsum_phase(kp, lds, vcu, G, wid, lane);
            ret_kv_phase(kp, vcu, G, wid, lane);
#endif
        } else if (ph == 5) {
#ifndef NO_R2
            ret_scan_phase<DRY>(kp, G, tid);
#endif
        } else if (ph == 6) {
#ifndef NO_R3
            ret_out_phase<DRY>(kp, lds, vcu, G, tid, wid, lane);
#endif
        } else if (ph == 8) {
#ifndef NO_ATTN
            unsigned char* ws = kp->ws;
            const attn_body::bf16* Qp = (const attn_body::bf16*)(ws + WS_Q); const attn_body::bf16* Kp = (const attn_body::bf16*)(ws + WS_K); const attn_body::bf16* Vp = (const attn_body::bf16*)(ws + WS_V);
            const float* C2 = (const float*)(ws + WS_C2);
            const int nun = (G == 256) ? 4 : (1024 - vcu + G - 1) / G;
#pragma unroll 1
            for (int i = 0; i < nun; ++i) {
                int bh, qb;
                if (G == 256) { const int s = vcu & 3; bh = vcu >> 2; qb = (i == 0) ? s : (i == 1) ? 7 - s : (i == 2) ? 8 + s : 15 - s; }
                else { const int idx = vcu + i * G; bh = idx >> 4; qb = idx & 15; }
                attn_body::attn_unit<32, DRY>(bh >> 4, bh & 15, qb, Qp, Kp, Vp, (const attn_body::bf16*)(ws + WS_KLEAD), (const attn_body::bf16*)(ws + WS_VLEAD), (attn_body::bf16*)(ws + WS_Q), C2, (char*)lds_raw);
            }
#endif
        }
}
#ifndef MULTI
#ifndef PROBE_PH
#define PROBE_PH -1
#endif
__global__ void __launch_bounds__(512, 2) fwd_megakernel(Params p_unused) {
    cg::grid_group grid = cg::this_grid();
    { volatile LAS unsigned* st = (volatile LAS unsigned*)((LAS unsigned char*)lds_raw + LDS_MISC);
      if (threadIdx.x == 0) { st[0] = 0u; st[1] = 0u; (void)xb_add((unsigned*)(kparams()->ws + WS_BAR) + XB_XCNT(xb_xcc_id()), 1u); }
      __syncthreads(); }
    if (gridDim.x > 65536u) grid.sync();
#pragma unroll 1
    for (int ph = 0; ph <= LAST_PHASE; ++ph) {
        if (PROBE_PH >= 0 && ph == PROBE_PH) { run_phase<true>(ph); xcd_barrier((unsigned*)(kparams()->ws + WS_BAR), (volatile LAS unsigned*)((LAS unsigned char*)lds_raw + LDS_MISC)); }
        run_phase<false>(ph);
        if (ph < 12) xcd_barrier((unsigned*)(kparams()->ws + WS_BAR), (volatile LAS unsigned*)((LAS unsigned char*)lds_raw + LDS_MISC));
    }
}
#else
template <int PH> __global__ void __launch_bounds__(512, 2) phase_kernel(Params p_unused) { run_phase<false>(PH); }
__global__ void __launch_bounds__(512, 2) gemm_kernel(Params p_unused, int ph) { run_phase<false>(ph == 1 ? 1 : ph == 2 ? 2 : ph == 3 ? 3 : ph == 7 ? 7 : ph == 9 ? 9 : ph == 10 ? 10 : ph == 11 ? 11 : 12); }
#endif

extern "C" void kernel_launch(void* const* d_in, const int* in_sizes, int n_in, void* d_out, int out_size, void* d_ws, size_t ws_size, hipStream_t stream) {
    static int grid = 0;
    if (grid == 0) {
        int dev = 0, cus = 0, per_cu = 0;
        if (hipGetDevice(&dev) != hipSuccess || hipDeviceGetAttribute(&cus, hipDeviceAttributeMultiprocessorCount, dev) != hipSuccess) { fprintf(stderr, "kernel_launch: device query failed\n"); grid = -1; return; }
#ifndef MULTI
        if (hipFuncSetAttribute((const void*)fwd_megakernel, hipFuncAttributeMaxDynamicSharedMemorySize, LDS_BYTES) != hipSuccess) { fprintf(stderr, "kernel_launch: hipFuncSetAttribute failed\n"); grid = -1; return; }
        if (hipOccupancyMaxActiveBlocksPerMultiprocessor(&per_cu, (const void*)fwd_megakernel, 512, LDS_BYTES) != hipSuccess || per_cu < 1) { fprintf(stderr, "kernel_launch: occupancy query says %d\n", per_cu); per_cu = 1; }
#else
        hipFuncSetAttribute((const void*)phase_kernel<0>, hipFuncAttributeMaxDynamicSharedMemorySize, LDS_BYTES);
        hipFuncSetAttribute((const void*)phase_kernel<4>, hipFuncAttributeMaxDynamicSharedMemorySize, LDS_BYTES);
        hipFuncSetAttribute((const void*)phase_kernel<5>, hipFuncAttributeMaxDynamicSharedMemorySize, LDS_BYTES);
        hipFuncSetAttribute((const void*)phase_kernel<6>, hipFuncAttributeMaxDynamicSharedMemorySize, LDS_BYTES);
        hipFuncSetAttribute((const void*)phase_kernel<8>, hipFuncAttributeMaxDynamicSharedMemorySize, LDS_BYTES);
        hipFuncSetAttribute((const void*)gemm_kernel, hipFuncAttributeMaxDynamicSharedMemorySize, LDS_BYTES);
#endif
        (void)hipGetLastError();
        grid = cus;
    }
    if (grid < 0) return;
    Params p{};
    p.x = (const float*)d_in[0]; p.meta = (const float*)d_in[1]; p.n1 = (const float*)d_in[2]; p.w1i = (const float*)d_in[3]; p.w1o = (const float*)d_in[4];
    p.nm = (const float*)d_in[5]; p.win = (const float*)d_in[6]; p.bfg = (const float*)d_in[7]; p.bgate = (const float*)d_in[8]; p.qn = (const float*)d_in[9];
    p.kn = (const float*)d_in[10]; p.wof = (const float*)d_in[11]; p.rgn = (const float*)d_in[12]; p.wor = (const float*)d_in[13]; p.wout = (const float*)d_in[14];
    p.n2 = (const float*)d_in[15]; p.w2i = (const float*)d_in[16]; p.w2o = (const float*)d_in[17];
    p.out = (float*)d_out; p.ws = (unsigned char*)d_ws;
#ifndef MULTI
    if (hipMemsetAsync((char*)d_ws + WS_BAR, 0, XCD_BAR_WORDS * 4, stream) != hipSuccess) { fprintf(stderr, "kernel_launch: memset failed\n"); return; }
    void* args[] = {&p};
    hipError_t e = hipLaunchCooperativeKernel((const void*)fwd_megakernel, dim3(grid), dim3(512), args, LDS_BYTES, stream);
    if (e != hipSuccess) fprintf(stderr, "cooperative launch failed: %s (grid %d)\n", hipGetErrorString(e), grid);
#else
    for (int ph = 0; ph <= LAST_PHASE; ++ph) {
        switch (ph) {
            case 0: hipLaunchKernelGGL(phase_kernel<0>, dim3(grid), dim3(512), LDS_BYTES, stream, p); break;
            case 4: hipLaunchKernelGGL(phase_kernel<4>, dim3(grid), dim3(512), LDS_BYTES, stream, p); break;
            case 5: hipLaunchKernelGGL(phase_kernel<5>, dim3(grid), dim3(512), LDS_BYTES, stream, p); break;
            case 6: hipLaunchKernelGGL(phase_kernel<6>, dim3(grid), dim3(512), LDS_BYTES, stream, p); break;
            case 8: hipLaunchKernelGGL(phase_kernel<8>, dim3(grid), dim3(512), LDS_BYTES, stream, p); break;
            default: hipLaunchKernelGGL(gemm_kernel, dim3(grid), dim3(512), LDS_BYTES, stream, p, ph); break;
        }
    }
#endif
}
```

```cpp
#include <hip/hip_runtime.h>
#include <hip/hip_cooperative_groups.h>
#include <hip/hip_bf16.h>
#include <cstdio>
#include <cstdint>
#include <cmath>
namespace cg = cooperative_groups;

#ifndef LAST_PHASE
#define LAST_PHASE 12
#endif

#define LAS __attribute__((address_space(3)))
typedef unsigned short bf16_t;
typedef short bf16x8 __attribute__((ext_vector_type(8)));
typedef float f32x4 __attribute__((ext_vector_type(4)));
typedef float f32x16 __attribute__((ext_vector_type(16)));
typedef unsigned u32x4 __attribute__((ext_vector_type(4)));
typedef unsigned u32x2 __attribute__((ext_vector_type(2)));
typedef short s16x4 __attribute__((ext_vector_type(4)));

constexpr int DM = 1024, NB = 4, SEQ = 4096, PP = 4224, MP = NB * PP  , DFF = 2816, NINC = 8208;
constexpr int NMP = MP / 256  , NMR = 64;
constexpr float LOG2E = 1.4426950408889634f;
constexpr float QC2 = 0.125f * LOG2E;

constexpr size_t MiB = 1u << 20;
constexpr size_t WS_SSQ1 = 1 * MiB, WS_SSQ2 = 2 * MiB + 256 * 1024, WS_SSQ0 = 3 * MiB + 512 * 1024, WS_LOGF = 4 * MiB + 768 * 1024;
constexpr size_t WS_COS = 6 * MiB, WS_SIN = 7 * MiB + 256 * 1024;
constexpr size_t WS_W1A = 9 * MiB, WS_W1B = 20 * MiB, WS_WIN = 25 * MiB + 512 * 1024, WS_WOF = 42 * MiB, WS_WOR = 44 * MiB, WS_WOUT = 46 * MiB;
constexpr size_t WS_W2A = 48 * MiB, WS_W2B = 59 * MiB;
constexpr size_t WS_XB = 65 * MiB;
constexpr size_t WS_BIG = 98 * MiB;
constexpr size_t WS_HID = WS_BIG;
constexpr size_t WS_RQ = WS_BIG, WS_RK = WS_BIG + 16 * MiB + 512 * 1024, WS_KT = WS_BIG + 33 * MiB, WS_VT = WS_BIG + 49 * MiB + 512 * 1024;
constexpr size_t WS_SRG = WS_BIG + 82 * MiB + 512 * 1024, WS_KVR = WS_BIG + 115 * MiB + 512 * 1024;
constexpr size_t WS_Q = WS_BIG, WS_K = WS_BIG + 33 * MiB, WS_V = WS_KVR;
constexpr size_t WS_T1 = WS_K, WS_GB = WS_V;
constexpr size_t WS_KLEAD = 128 * 1024, WS_VLEAD = 384 * 1024;
constexpr size_t WS_C2 = 9 * MiB;
static_assert(WS_KVR + 33 * MiB + 512 * 1024 <= 256 * MiB, "ws map");
constexpr int WIN_RET = 0, WIN_FOX = 3328, WIN_GA = 6400, WIN_GB = 7424, WIN_ROWS = 8448;

struct Params {
    const float* x; const float* meta; const float* n1; const float* w1i; const float* w1o; const float* nm; const float* win;
    const float* bfg; const float* bgate; const float* qn; const float* kn; const float* wof; const float* rgn; const float* wor;
    const float* wout; const float* n2; const float* w2i; const float* w2o;
    float* out; unsigned char* ws;
};

typedef const __attribute__((address_space(4))) Params* KP;
__device__ __forceinline__ Params ldp(KP kp) { Params p; p.x = kp->x; p.meta = kp->meta; p.n1 = kp->n1; p.w1i = kp->w1i; p.w1o = kp->w1o; p.nm = kp->nm; p.win = kp->win; p.bfg = kp->bfg; p.bgate = kp->bgate; p.qn = kp->qn; p.kn = kp->kn; p.wof = kp->wof; p.rgn = kp->rgn; p.wor = kp->wor; p.wout = kp->wout; p.n2 = kp->n2; p.w2i = kp->w2i; p.w2o = kp->w2o; p.out = kp->out; p.ws = kp->ws; return p; }
__device__ __forceinline__ KP kparams() { KP kp = (KP)__builtin_amdgcn_kernarg_segment_ptr(); asm volatile("" : "+s"(kp)); return kp; }
typedef float f32x2c __attribute__((ext_vector_type(2))); typedef __bf16 bf16x2c __attribute__((ext_vector_type(2)));
__device__ __forceinline__ unsigned cvt_pk_bf16(float lo, float hi) { const f32x2c v = {lo, hi}; const bf16x2c b = __builtin_convertvector(v, bf16x2c); return __builtin_bit_cast(unsigned, b); }
__device__ __forceinline__ float bf_lo(unsigned w) { return __uint_as_float(w << 16); }
__device__ __forceinline__ float bf_hi(unsigned w) { return __uint_as_float(w & 0xffff0000u); }
__device__ __forceinline__ float silu_f(float v) { return v * __builtin_amdgcn_rcpf(1.0f + __builtin_amdgcn_exp2f(-v * LOG2E)); }
__device__ __forceinline__ float sigm_f(float v) { return __builtin_amdgcn_rcpf(1.0f + __builtin_amdgcn_exp2f(-v * LOG2E)); }
__device__ __forceinline__ u32x4 pack8(f32x4 a, f32x4 b) { u32x4 w; w.x = cvt_pk_bf16(a[0], a[1]); w.y = cvt_pk_bf16(a[2], a[3]); w.z = cvt_pk_bf16(b[0], b[1]); w.w = cvt_pk_bf16(b[2], b[3]); return w; }
__device__ __forceinline__ u32x2 pack4(f32x4 a) { u32x2 w; w.x = cvt_pk_bf16(a[0], a[1]); w.y = cvt_pk_bf16(a[2], a[3]); return w; }
__device__ __forceinline__ float row_rstd(const float* ssq, int row, int fq) {
    const f32x4 v = *(const f32x4*)(ssq + (size_t)row * 16 + 4 * fq);
    float s = (v[0] + v[1]) + (v[2] + v[3]);
    s += __shfl_xor(s, 16); s += __shfl_xor(s, 32);
    return rsqrtf(s * (1.0f / 1024.0f) + 1e-6f);
}
__device__ __forceinline__ float wave_sum(float v) {
#pragma unroll
    for (int o = 1; o < 64; o <<= 1) v += __shfl_xor(v, o);
    return v;
}
#define LDS_WAIT() asm volatile("s_waitcnt lgkmcnt(0)" ::: "memory")

namespace pg8 {
constexpr int BM = 256, BK = 64, HALF = 128, HTB = HALF * BK * 2, NXCD = 8, WGM = 4;
__device__ __forceinline__ int lds_byte(int r, int c) { const int st = (r >> 4) * 2 + (c >> 5), rr = r & 15, cc = c & 31, ob = rr * 64 + cc * 2; return st * 1024 + (ob ^ (((ob >> 9) & 1) << 5)); }
__device__ __forceinline__ void stage_rc(int b, int& R, int& C) { const int st = b / 1024, sb = b % 1024, swz = sb ^ (((sb >> 9) & 1) << 5); R = (st >> 1) * 16 + swz / 64; C = (st & 1) * 32 + (swz % 64) / 2; }
__device__ __forceinline__ int perm32(int rho) { const int n = rho >> 4, i = rho & 15; return 8 * (i >> 2) + 4 * n + (i & 3); }

struct Unit { const char* a; const char* b; unsigned meta; };

enum Kind { K_SWIGLU = 0, K_RES1, K_RES2, K_FINAL, K_RQ, K_RK, K_RV, K_RG, K_FF, K_FQ, K_FK, K_FV, K_GA, K_MIXA, K_GB, K_MIXB };
enum GPhase { GP_G1 = 0, GP_G2, GP_G3R, GP_G3F, GP_MIX, GP_OUT, GP_F2A, GP_F2B };

struct Sched {
    int gp, G, c;
    __device__ __forceinline__ void init(int gp_, int G_, int c_) { gp = gp_; G = G_; c = c_; }
    __device__ __forceinline__ int kdim() const { return (gp == GP_G2 || gp == GP_F2B) ? DFF : 1024; }
    __device__ __forceinline__ bool next(int i, Unit& u) const {
        int nN, nM = NMR, real = 1, chain = 1;
        switch (gp) {
            case GP_G1: nN = 22; nM = NMP; real = 0; break;
            case GP_G2: nN = 4; break;
            case GP_G3R: nN = 13; break;
            case GP_G3F: nN = 12; break;
            case GP_MIX: nN = 4; chain = 4; break;
            case GP_OUT: nN = 4; break;
            case GP_F2A: nN = 22; break;
            default: nN = 4; break;
        }
        const int K = kdim(), nwg = nM * nN;
        const int ti = (chain == 4) ? (i >> 2) : i, sub = (chain == 4) ? (i & 3) : 0;
        const long L = (long)ti * G + c;
        if (gp == GP_G3R && L >= nwg) {
            const int j = (int)(L - nwg); if (j >= 15) return false;
            int kind, aux, brow;
            if (j < 2) { kind = K_RK; aux = j; brow = WIN_RET + (2 + j) * 256; } else if (j < 6) { kind = K_RV; aux = j - 2; brow = WIN_RET + (2 + j) * 256; }
            else if (j == 6) { kind = K_FF; aux = 0; brow = WIN_RET + 12 * 256; } else if (j < 11) { kind = K_FK; aux = (j - 7) | 4; brow = WIN_FOX + (j - 3) * 256; }
            else { kind = K_FV; aux = (j - 11) | 4; brow = WIN_FOX + (j - 3) * 256; }
            u.meta = ((unsigned)kind << 21) | ((unsigned)aux << 25);
            const char* ws = (const char*)kparams()->ws;
            u.a = ws + WS_XB; u.b = ws + WS_WIN + (size_t)brow * K * 2;
            return true;
        }
        if (L >= nwg) return false;
        int wgid = (int)L; { const int q = nwg / NXCD, r = nwg % NXCD, xcd = wgid % NXCD, off = wgid / NXCD; wgid = (xcd < r ? xcd * (q + 1) : r * (q + 1) + (xcd - r) * q) + off; }
        const int nig = WGM * nN, gid = wgid / nig, fm = gid * WGM, gsz = (nM - fm) < WGM ? (nM - fm) : WGM;
        const int pm = fm + ((wgid % nig) % gsz), pn = (wgid % nig) / gsz;
        const int row0 = real ? ((pm >> 4) * PP + 128 + (pm & 15) * 256) : pm * 256;
        int aux = 0;
        size_t aoff = WS_XB, boff = 0; int brow = pn * 256, kind = 0;
        switch (gp) {
            case GP_G1: boff = WS_W1A; kind = K_SWIGLU; break;
            case GP_G2: aoff = WS_HID; boff = WS_W1B; kind = K_RES1; break;
            case GP_G3R: boff = WS_WIN; brow = WIN_RET + pn * 256;
                if (pn < 2) { kind = K_RQ; aux = pn; } else if (pn < 4) { kind = K_RK; aux = pn - 2; } else if (pn < 8) { kind = K_RV; aux = pn - 4; } else if (pn < 12) { kind = K_RG; aux = pn - 8; } else kind = K_FF;
                break;
            case GP_G3F: boff = WS_WIN; brow = WIN_FOX + pn * 256;
                if (pn < 4) { kind = K_FQ; aux = pn; } else if (pn < 8) { kind = K_FK; aux = pn - 4; } else { kind = K_FV; aux = pn - 8; }
                break;
            case GP_MIX:
                if (sub == 0) { boff = WS_WIN; brow = WIN_GA + pn * 256; kind = K_GA; }
                else if (sub == 1) { aoff = WS_Q; boff = WS_WOF; kind = K_MIXA; }
                else if (sub == 2) { boff = WS_WIN; brow = WIN_GB + pn * 256; kind = K_GB; }
                else { aoff = WS_SRG; boff = WS_WOR; kind = K_MIXB; }
                break;
            case GP_OUT: aoff = WS_T1; boff = WS_WOUT; kind = K_RES2; break;
            case GP_F2A: boff = WS_W2A; kind = K_SWIGLU; aux = 1; break;
            default: aoff = WS_HID; boff = WS_W2B; kind = K_FINAL; break;
        }
        u.meta = (unsigned)row0 | ((unsigned)pn << 16) | ((unsigned)kind << 21) | ((unsigned)aux << 25);
        const char* ws = (const char*)kparams()->ws;
        u.a = ws + aoff + (size_t)row0 * K * 2;
        u.b = ws + boff + (size_t)brow * K * 2;
        return true;
    }
};

struct Epi {
    __device__ __forceinline__ void operator()(const f32x4 (&acc)[2][2][4][2], const Unit& u, int wr, int wc, int fr, int fq) const {
        asm volatile("" : "+v"(fr), "+v"(fq), "+s"(wr), "+s"(wc));
        const KP kp = kparams();
        unsigned char* ws = kp->ws;
        const int kind = (u.meta >> 21) & 15, pn = (u.meta >> 16) & 31, u_aux = (u.meta >> 25) & 7, u_row0 = u.meta & 0xffff, u_col0 = pn << 8;
        float rsv[2][4];
        if (!(kind == K_RES1 || kind == K_RES2 || kind == K_FINAL || kind == K_MIXA || kind == K_MIXB)) {
            const float* ssqp = (const float*)(ws + (kind == K_SWIGLU ? (u_aux ? WS_SSQ2 : WS_SSQ0) : WS_SSQ1));
            f32x4 sv[2][4];
#pragma unroll
            for (int ai = 0; ai < 2; ++ai)
#pragma unroll
                for (int m = 0; m < 4; ++m) sv[ai][m] = *(const f32x4*)(ssqp + (size_t)(u_row0 + ai * 128 + wr * 64 + m * 16 + fr) * 16 + 4 * fq);
#pragma unroll
            for (int ai = 0; ai < 2; ++ai)
#pragma unroll
                for (int m = 0; m < 4; ++m) { float sx = (sv[ai][m][0] + sv[ai][m][1]) + (sv[ai][m][2] + sv[ai][m][3]); sx += __shfl_xor(sx, 16); sx += __shfl_xor(sx, 32); rsv[ai][m] = rsqrtf(sx * (1.0f / 1024.0f) + 1e-6f); }
        } else {
#pragma unroll
            for (int ai = 0; ai < 2; ++ai)
#pragma unroll
                for (int m = 0; m < 4; ++m) rsv[ai][m] = 1.0f;
        }
#define FOR_ROWS _Pragma("unroll") for (int ai = 0; ai < 2; ++ai) _Pragma("unroll") for (int m = 0; m < 4; ++m)
#define ROWDEF const int row = u_row0 + ai * 128 + wr * 64 + m * 16 + fr
        if (kind == K_SWIGLU) {
            const float* ssq = (const float*)(ws + (u_aux ? WS_SSQ2 : WS_SSQ0));
            bf16_t* H = (bf16_t*)(ws + WS_HID);
            const int hc = (u_col0 >> 1) + wc * 32 + 8 * fq;
            FOR_ROWS { ROWDEF; const float rs = rsv[ai][m];
                f32x4 o[2];
#pragma unroll
                for (int n = 0; n < 2; ++n) { const f32x4 a = acc[ai][0][m][n] * rs, b = acc[ai][1][m][n] * rs;
#pragma unroll
                    for (int e = 0; e < 4; ++e) o[n][e] = silu_f(a[e]) * b[e]; }
                *(u32x4*)(H + (size_t)row * DFF + hc) = pack8(o[0], o[1]); }
        } else if (kind == K_RES1 || kind == K_RES2 || kind == K_FINAL) {
            float* ssq = (float*)(ws + (kind == K_RES1 ? WS_SSQ1 : WS_SSQ2));
            bf16_t* HB = (bf16_t*)(ws + WS_XB);
            const float sc = (kind == K_RES2) ? 1.0f : 0.5f;
            const int c0 = u_col0 + wc * 32 + 8 * fq;
#pragma unroll
            for (int aim = 0; aim < 4; ++aim) { const int ai = aim >> 1, m0 = 2 * (aim & 1);
                f32x4 bs[4][2][2]; u32x4 hb[4][2];
#pragma unroll
                for (int m = m0; m < m0 + 2; ++m) { ROWDEF; const int b = row / PP, pidx = row - b * PP;
                    if (false) {
                    } else {
#pragma unroll
                        for (int bj = 0; bj < 2; ++bj) { hb[m][bj] = *(const u32x4*)(HB + (size_t)row * DM + c0 + bj * 128); bs[m][bj][0] = (f32x4){0.f, 0.f, 0.f, 0.f}; bs[m][bj][1] = bs[m][bj][0]; }
                    } }
                asm volatile("" ::: "memory");
#pragma unroll
                for (int m = m0; m < m0 + 2; ++m) { ROWDEF; const int b = row / PP, pidx = row - b * PP; float ss = 0.f;
                    float* op = kp->out + ((size_t)(b * SEQ + pidx - 128)) * DM + c0;
#pragma unroll
                    for (int bj = 0; bj < 2; ++bj) {
                        f32x4 b0 = bs[m][bj][0], b1 = bs[m][bj][1];
                        { const u32x4 t = hb[m][bj]; b0 = (f32x4){bf_lo(t.x), bf_hi(t.x), bf_lo(t.y), bf_hi(t.y)}; b1 = (f32x4){bf_lo(t.z), bf_hi(t.z), bf_lo(t.w), bf_hi(t.w)}; }
                        const f32x4 v0 = b0 + acc[ai][bj][m][0] * sc, v1 = b1 + acc[ai][bj][m][1] * sc;
                        if (kind == K_FINAL) { *(f32x4*)(op + bj * 128) = v0; *(f32x4*)(op + bj * 128 + 4) = v1; }
                        else { *(u32x4*)(HB + (size_t)row * DM + c0 + bj * 128) = pack8(v0, v1);
                            ss += (v0[0] * v0[0] + v0[1] * v0[1]) + (v0[2] * v0[2] + v0[3] * v0[3]) + (v1[0] * v1[0] + v1[1] * v1[1]) + (v1[2] * v1[2] + v1[3] * v1[3]); }
                    }
                    if (kind != K_FINAL) { ss += __shfl_xor(ss, 16); ss += __shfl_xor(ss, 32);
                        if (fq == 0) ssq[(size_t)row * 16 + pn * 4 + wc] = ss; } }
            }
        } else if (kind == K_RQ || kind == K_RK) {
            const float* ssq = (const float*)(ws + WS_SSQ1);
            const float* COS = (const float*)(ws + WS_COS); const float* SIN = (const float*)(ws + WS_SIN);
            const int hh = wc >> 1, i0 = 32 * (wc & 1) + 8 * fq, hd = 2 * u_aux + hh;
            bf16_t* RQ = (bf16_t*)(ws + (kind == K_RQ ? WS_RQ : WS_RK)); bf16_t* KT = (bf16_t*)(ws + WS_KT);
#pragma unroll
            for (int aim = 0; aim < 4; ++aim) { const int ai = aim >> 1, m0 = 2 * (aim & 1);
                f32x4 csv[4][2], snv[4][2];
#pragma unroll
                for (int m = m0; m < m0 + 2; ++m) { ROWDEF; const int b = row / PP, pidx = row - b * PP;
#pragma unroll
                    for (int n = 0; n < 2; ++n) { csv[m][n] = *(const f32x4*)(COS + (size_t)pidx * 64 + i0 + 4 * n); snv[m][n] = *(const f32x4*)(SIN + (size_t)pidx * 64 + i0 + 4 * n); } }
#pragma unroll
                for (int m = m0; m < m0 + 2; ++m) { ROWDEF; const float rs = rsv[ai][m]; const int b = row / PP, pidx = row - b * PP;
                    const float ksc = (kind == K_RK) ? (pidx >= 112 ? 0.08838834764831845f : 0.f) : 1.0f;
#pragma unroll
                    for (int n = 0; n < 2; ++n) {
                        const f32x4 cs = csv[m][n], sn = snv[m][n];
                        const f32x4 x1 = acc[ai][0][m][n] * rs, x2 = acc[ai][1][m][n] * rs;
                        const f32x4 y1 = (x1 * cs - x2 * sn) * ksc, y2 = (x2 * cs + x1 * sn) * ksc;
                        bf16_t* o = RQ + (size_t)row * 512 + hd * 128 + i0 + 4 * n;
                        *(u32x2*)o = pack4(y1); *(u32x2*)(o + 64) = pack4(y2);
                        if (kind == K_RK) {
                            bf16_t* kt = KT + ((size_t)((b * 4 + hd) * 128 + i0 + 4 * n)) * PP + pidx;
#pragma unroll
                            for (int e = 0; e < 4; ++e) { kt[(size_t)e * PP] = (bf16_t)cvt_pk_bf16(y1[e], 0.f); kt[(size_t)(64 + e) * PP] = (bf16_t)cvt_pk_bf16(y2[e], 0.f); }
                        }
                    } }
            }
        } else if (kind == K_RV) {
            const float* ssq = (const float*)(ws + WS_SSQ1); bf16_t* VT = (bf16_t*)(ws + WS_VT); const int hd = u_aux;
            FOR_ROWS { ROWDEF; float rs = rsv[ai][m]; const int b = row / PP, pidx = row - b * PP; if (pidx < 112) rs = 0.f;
#pragma unroll
                for (int bj = 0; bj < 2; ++bj)
#pragma unroll
                    for (int n = 0; n < 2; ++n) { const f32x4 v = acc[ai][bj][m][n] * rs; const int e0 = 128 * bj + 32 * wc + 8 * fq + 4 * n;
                        bf16_t* vt = VT + ((size_t)((b * 4 + hd) * 256 + e0)) * PP + pidx;
#pragma unroll
                        for (int e = 0; e < 4; ++e) vt[(size_t)e * PP] = (bf16_t)cvt_pk_bf16(v[e], 0.f); } }
        } else if (kind == K_RG || kind == K_FV) {
            const float* ssq = (const float*)(ws + WS_SSQ1); const bool lead = (u_aux & 4) != 0; bf16_t* O = (bf16_t*)(ws + (kind == K_RG ? WS_SRG : (lead ? WS_VLEAD : WS_V)));
            const int c0 = 256 * (u_aux & 3) + wc * 32 + 8 * fq;
            FOR_ROWS { ROWDEF; const float rs = rsv[ai][m];
#pragma unroll
                for (int bj = 0; bj < 2; ++bj) { f32x4 v0 = acc[ai][bj][m][0] * rs, v1 = acc[ai][bj][m][1] * rs;
                    if (kind == K_RG) {
#pragma unroll
                        for (int e = 0; e < 4; ++e) { v0[e] = silu_f(v0[e]); v1[e] = silu_f(v1[e]); } }
                    if (!lead || row < 128) *(u32x4*)(O + (size_t)row * DM + c0 + bj * 128) = pack8(v0, v1); } }
        } else if (kind == K_FF) {
            const float* ssq = (const float*)(ws + WS_SSQ1); float* LF = (float*)(ws + WS_LOGF);
            float fb[2][4];
#pragma unroll
            for (int n = 0; n < 2; ++n)
#pragma unroll
                for (int e = 0; e < 4; ++e) fb[n][e] = kp->bfg[(8 * fq + 4 * n + e) & 15];
            FOR_ROWS { ROWDEF; const float rs = rsv[ai][m]; const int b = row / PP, pidx = row - b * PP;
                if (wc == 0 && fq < 2) {
#pragma unroll
                    for (int n = 0; n < 2; ++n)
#pragma unroll
                        for (int e = 0; e < 4; ++e) { const int hx = 8 * fq + 4 * n + e; const float v = acc[ai][0][m][n][e] * rs + fb[n][e];
                            const float lf = fminf(v, 0.f) * LOG2E - __builtin_amdgcn_logf(1.0f + __builtin_amdgcn_exp2f(-fabsf(v) * LOG2E));
                            LF[((size_t)(b * 16 + hx)) * PP + pidx] = (pidx >= 112) ? lf : 0.f; } } }
        } else if (kind == K_FQ || kind == K_FK) {
            const float* ssq = (const float*)(ws + WS_SSQ1); const bool lead = (u_aux & 4) != 0; bf16_t* O = (bf16_t*)(ws + (kind == K_FQ ? WS_Q : (lead ? WS_KLEAD : WS_K)));
            const float* gn = (kind == K_FQ) ? kp->qn : kp->kn; const float osc = (kind == K_FQ) ? QC2 : 1.0f;
            const int head = 4 * (u_aux & 3) + wc;
            f32x4 gq[2][2];
#pragma unroll
            for (int bj = 0; bj < 2; ++bj) { gq[bj][0] = *(const f32x4*)(gn + 32 * bj + 8 * fq); gq[bj][1] = *(const f32x4*)(gn + 32 * bj + 8 * fq + 4); }
            FOR_ROWS { ROWDEF; const float rs = rsv[ai][m];
                f32x4 v[2][2]; float ss = 0.f;
#pragma unroll
                for (int bj = 0; bj < 2; ++bj)
#pragma unroll
                    for (int n = 0; n < 2; ++n) { v[bj][n] = acc[ai][bj][m][n] * rs; const f32x4 t = v[bj][n]; ss += (t[0] * t[0] + t[1] * t[1]) + (t[2] * t[2] + t[3] * t[3]); }
                ss += __shfl_xor(ss, 16); ss += __shfl_xor(ss, 32);
                const float r2 = rsqrtf(ss * (1.0f / 64.0f) + 1e-6f) * osc;
#pragma unroll
                for (int bj = 0; bj < 2; ++bj) { const f32x4 g0 = gq[bj][0], g1 = gq[bj][1];
                    if (!lead || row < 128) *(u32x4*)(O + (size_t)row * DM + head * 64 + 32 * bj + 8 * fq) = pack8(v[bj][0] * g0 * r2, v[bj][1] * g1 * r2); } }
        } else if (kind == K_GA || kind == K_GB) {
            bf16_t* O = (bf16_t*)(ws + (kind == K_GA ? WS_T1 : WS_GB));
            const int c0 = u_col0 + wc * 32 + 8 * fq;
            f32x4 gq[2][2];
#pragma unroll
            for (int bj = 0; bj < 2; ++bj) { const float* bg = kp->bgate + (kind == K_GB ? 1024 : 0) + c0 + bj * 128; gq[bj][0] = *(const f32x4*)bg; gq[bj][1] = *(const f32x4*)(bg + 4); }
            FOR_ROWS { ROWDEF; const float rs = rsv[ai][m];
#pragma unroll
                for (int bj = 0; bj < 2; ++bj) { const int c = c0 + bj * 128; f32x4 v0 = acc[ai][bj][m][0], v1 = acc[ai][bj][m][1];
#pragma unroll
                    for (int e = 0; e < 4; ++e) { v0[e] = sigm_f(v0[e] * rs + gq[bj][0][e]); v1[e] = sigm_f(v1[e] * rs + gq[bj][1][e]); }
                    *(u32x4*)(O + (size_t)row * DM + c) = pack8(v0, v1); } }
        } else {
            bf16_t* T1 = (bf16_t*)(ws + WS_T1); bf16_t* GB = (bf16_t*)(ws + WS_GB);
            const int c0 = u_col0 + wc * 32 + 8 * fq;
#pragma unroll
            for (int aim = 0; aim < 4; ++aim) { const int ai = aim >> 1, m0 = 2 * (aim & 1);
                u32x4 tt[4][2], gg[4][2];
#pragma unroll
                for (int m = m0; m < m0 + 2; ++m) { ROWDEF;
#pragma unroll
                    for (int bj = 0; bj < 2; ++bj) { tt[m][bj] = *(const u32x4*)(T1 + (size_t)row * DM + c0 + bj * 128); gg[m][bj] = (u32x4){0u, 0u, 0u, 0u}; if (kind == K_MIXB) gg[m][bj] = *(const u32x4*)(GB + (size_t)row * DM + c0 + bj * 128); } }
#pragma unroll
                for (int m = m0; m < m0 + 2; ++m) { ROWDEF;
#pragma unroll
                    for (int bj = 0; bj < 2; ++bj) { f32x4 v0 = acc[ai][bj][m][0], v1 = acc[ai][bj][m][1]; const u32x4 t = tt[m][bj], g = gg[m][bj];
                        if (kind == K_MIXA) {
                            v0[0] *= bf_lo(t.x); v0[1] *= bf_hi(t.x); v0[2] *= bf_lo(t.y); v0[3] *= bf_hi(t.y); v1[0] *= bf_lo(t.z); v1[1] *= bf_hi(t.z); v1[2] *= bf_lo(t.w); v1[3] *= bf_hi(t.w);
                        } else {
                            v0[0] = bf_lo(t.x) + bf_lo(g.x) * v0[0]; v0[1] = bf_hi(t.x) + bf_hi(g.x) * v0[1]; v0[2] = bf_lo(t.y) + bf_lo(g.y) * v0[2]; v0[3] = bf_hi(t.y) + bf_hi(g.y) * v0[3];
                            v1[0] = bf_lo(t.z) + bf_lo(g.z) * v1[0]; v1[1] = bf_hi(t.z) + bf_hi(g.z) * v1[1]; v1[2] = bf_lo(t.w) + bf_lo(g.w) * v1[2]; v1[3] = bf_hi(t.w) + bf_hi(g.w) * v1[3];
                        }
                        *(u32x4*)(T1 + (size_t)row * DM + c0 + bj * 128) = pack8(v0, v1); } }
            }
        }
#undef FOR_ROWS
#undef ROWDEF
    }
};

__device__ __forceinline__ void gemm_phase(LAS unsigned char* lds, const Sched& S, const Epi& E) {
    int tid_ = threadIdx.x; asm volatile("" : "+v"(tid_));
    const int tid = tid_, wid = __builtin_amdgcn_readfirstlane(tid >> 6), lane = tid & 63, wr = wid >> 2, wc = wid & 3, fr = lane & 15, fq = lane >> 4;
    const int K = S.kdim(), nt = K / BK;
    unsigned voffA[2], voffB[2];
#pragma unroll
    for (int i = 0; i < 2; ++i) { int R, C; stage_rc(tid * 16 + i * 8192, R, C); const int Rb = (R & ~31) + perm32(R & 31);
        voffA[i] = (unsigned)(R * K + C) * 2u; voffB[i] = (unsigned)(Rb * K + C) * 2u; }
    const size_t kstep = (size_t)(BK * 2);
    const size_t hstep = (size_t)HALF * K * 2;
    const unsigned ldsw = (unsigned)wid * 1024u;
    const int aoff = lds_byte(wr * 64 + fr, fq * 8), boff = lds_byte(wc * 32 + fr, fq * 8);
#define PG8_SA(b, h) (((b) * 2 + (h)) * HTB)
#define PG8_SB(b, h) ((4 + (b) * 2 + (h)) * HTB)
#define PG8_STAGE(bufoff, gbase, voff) do { _Pragma("unroll") for (int _i = 0; _i < 2; ++_i) \
        __builtin_amdgcn_global_load_lds((const unsigned*)((const char*)(gbase) + (voff)[_i]), (LAS unsigned*)(lds + (bufoff) + ldsw + _i * 8192), 16, 0, 0); } while (0)
#define PG8_LDA(dst, b, h) do { _Pragma("unroll") for (int m = 0; m < 4; ++m) _Pragma("unroll") for (int k = 0; k < 2; ++k) dst[m][k] = *(const LAS bf16x8*)(lds + PG8_SA(b, h) + aoff + m * 2048 + k * 1024); } while (0)
#define PG8_LDB(dst, b, h) do { _Pragma("unroll") for (int n = 0; n < 2; ++n) _Pragma("unroll") for (int k = 0; k < 2; ++k) dst[n][k] = *(const LAS bf16x8*)(lds + PG8_SB(b, h) + boff + n * 2048 + k * 1024); } while (0)
#define PG8_MMA(ai, bj, At, Bt) do { __builtin_amdgcn_s_setprio(1); _Pragma("unroll") for (int m = 0; m < 4; ++m) _Pragma("unroll") for (int n = 0; n < 2; ++n) _Pragma("unroll") for (int k = 0; k < 2; ++k) \
        acc[ai][bj][m][n] = __builtin_amdgcn_mfma_f32_16x16x32_bf16(Bt[n][k], At[m][k], acc[ai][bj][m][n], 0, 0, 0); __builtin_amdgcn_s_setprio(0); } while (0)
#define PG8_WAIT_V(n) asm volatile("s_waitcnt vmcnt(" #n ")" ::: "memory")
#define PG8_WAIT_L(n) asm volatile("s_waitcnt lgkmcnt(" #n ")" ::: "memory")
#define PG8_BAR __builtin_amdgcn_s_barrier()
#define PG8_SCHED __builtin_amdgcn_sched_barrier(0)
    Unit cur, nxt; int ui = 0;
    if (!S.next(0, cur)) return;
    f32x4 acc[2][2][4][2];
#pragma unroll
    for (int a = 0; a < 2; ++a)
#pragma unroll
        for (int b = 0; b < 2; ++b)
#pragma unroll
            for (int m = 0; m < 4; ++m)
#pragma unroll
                for (int n = 0; n < 2; ++n) acc[a][b][m][n] = (f32x4){0.f, 0.f, 0.f, 0.f};
    bf16x8 At[4][2], B0[2][2], B1[2][2];
    const char* cA = cur.a; const char* cB = cur.b;
    PG8_STAGE(PG8_SB(0, 0), cB, voffB); PG8_STAGE(PG8_SB(0, 1), cB + hstep, voffB); PG8_STAGE(PG8_SA(0, 0), cA, voffA); PG8_STAGE(PG8_SA(0, 1), cA + hstep, voffA);
    if (wr == 1) PG8_BAR;
    PG8_WAIT_V(2); PG8_BAR;
    PG8_STAGE(PG8_SB(1, 0), cB + kstep, voffB); PG8_STAGE(PG8_SA(1, 0), cA + kstep, voffA); PG8_STAGE(PG8_SB(1, 1), cB + hstep + kstep, voffB);
    PG8_WAIT_V(6); PG8_BAR;
    for (;;) {
        const bool has_next = S.next(ui + 1, nxt);
        const char* nA = has_next ? nxt.a : cA; const char* nB = has_next ? nxt.b : cB;
        for (int t = 0; t < nt; t += 2) {
            const bool last = (t == nt - 2);
            const char* a1 = cA + (size_t)(t + 1) * kstep;
            const char* a2 = last ? nA : cA + (size_t)(t + 2) * kstep; const char* b2 = last ? nB : cB + (size_t)(t + 2) * kstep;
            const char* a3 = a2 + kstep; const char* b3 = b2 + kstep;
            PG8_LDB(B0, 0, 0); PG8_LDB(B1, 0, 1); PG8_SCHED; PG8_LDA(At, 0, 0); PG8_STAGE(PG8_SA(1, 1), a1 + hstep, voffA);
            PG8_WAIT_V(8); PG8_WAIT_L(0); PG8_BAR; PG8_MMA(0, 0, At, B0); PG8_MMA(0, 1, At, B1); PG8_BAR; PG8_SCHED;
            PG8_LDA(At, 0, 1); PG8_STAGE(PG8_SB(0, 0), b2, voffB); PG8_STAGE(PG8_SB(0, 1), b2 + hstep, voffB); PG8_STAGE(PG8_SA(0, 0), a2, voffA);
            PG8_WAIT_V(8); PG8_WAIT_L(0); PG8_BAR; PG8_MMA(1, 0, At, B0); PG8_MMA(1, 1, At, B1); PG8_BAR; PG8_SCHED;
            PG8_LDB(B0, 1, 0); PG8_LDB(B1, 1, 1); PG8_SCHED; PG8_LDA(At, 1, 0); PG8_STAGE(PG8_SA(0, 1), a2 + hstep, voffA);
            PG8_WAIT_V(8); PG8_WAIT_L(0); PG8_BAR; PG8_MMA(0, 0, At, B0); PG8_MMA(0, 1, At, B1); PG8_BAR; PG8_SCHED;
            PG8_LDA(At, 1, 1); PG8_STAGE(PG8_SB(1, 0), b3, voffB); PG8_STAGE(PG8_SB(1, 1), b3 + hstep, voffB); PG8_STAGE(PG8_SA(1, 0), a3, voffA);
            PG8_WAIT_V(8); PG8_WAIT_L(0); PG8_BAR; PG8_MMA(1, 0, At, B0); PG8_MMA(1, 1, At, B1); PG8_BAR; PG8_SCHED;
        }
        if (wr == 0) PG8_BAR;
        E(acc, cur, wr, wc, fr, fq);
        if (!has_next) break;
#pragma unroll
        for (int a = 0; a < 2; ++a)
#pragma unroll
            for (int b = 0; b < 2; ++b)
#pragma unroll
                for (int m = 0; m < 4; ++m)
#pragma unroll
                    for (int n = 0; n < 2; ++n) acc[a][b][m][n] = (f32x4){0.f, 0.f, 0.f, 0.f};
        cur = nxt; cA = nA; cB = nB; ++ui;
        if (wr == 1) PG8_BAR;
    }
    PG8_WAIT_V(0);
    PG8_BAR;
#undef PG8_SA
#undef PG8_SB
#undef PG8_STAGE
#undef PG8_LDA
#undef PG8_LDB
#undef PG8_MMA
#undef PG8_WAIT_V
#undef PG8_WAIT_L
#undef PG8_BAR
#undef PG8_SCHED
}
}

namespace attn_body {
using bf16 = __hip_bfloat16;
constexpr int D = 64, NW = 8, QBLK = 32, QB = QBLK * NW, KVBLK = 64;
__device__ __forceinline__ int crow(int r, int hi) { return (r & 3) + 8 * (r >> 2) + 4 * hi; }
#define SBAR() __builtin_amdgcn_sched_barrier(0)
__device__ __forceinline__ void cmask(f32x16& p0, f32x16& p1, int jb, int qrel, int hi) {
    const float NEG = -INFINITY; int kb = 64 * jb + 4 * hi;
#pragma unroll
    for (int r = 0; r < 16; ++r) { int kv = kb + (r & 3) + 8 * (r >> 2); if (kv > qrel) p0[r] = NEG; if (kv + 32 > qrel) p1[r] = NEG; }
}
constexpr int NSLOT = 3, SLOTB = 8192;
constexpr int LDS_K = 0, LDS_V = NSLOT * SLOTB, LDS_WS = 2 * NSLOT * SLOTB, LDS_OST = LDS_WS + NW * 64 * 4, LDS_BYTES = LDS_OST + NW * 4096;
constexpr int LDS_C2 = 86016, LDS_C2T = 103424;
__device__ __forceinline__ void glds16(const void* gsrc, unsigned lds_dst) { unsigned keep;
    asm volatile("s_mov_b32 %0, m0\n\ts_mov_b32 m0, %2\n\ts_nop 0\n\tglobal_load_lds_dwordx4 %1, off\n\ts_mov_b32 m0, %0" : "=&s"(keep) : "v"(gsrc), "s"(lds_dst) : "memory"); }
__device__ __forceinline__ float max3f(float a, float b, float c) { float r; asm("v_max3_f32 %0, %1, %2, %3" : "=v"(r) : "v"(a), "v"(b), "v"(c)); return r; }
__device__ __forceinline__ float max2f(float a, float b) { float r; asm("v_max_f32_e32 %0, %1, %2" : "=v"(r) : "v"(a), "v"(b)); return r; }
__device__ __forceinline__ float fadd_s(float a, float b) { float r; asm("v_add_f32_e32 %0, %1, %2" : "=v"(r) : "v"(a), "v"(b)); return r; }
__device__ __forceinline__ float fsub_s(float a, float b) { float r; asm("v_sub_f32_e32 %0, %1, %2" : "=v"(r) : "v"(a), "v"(b)); return r; }
typedef float f32x2_t __attribute__((ext_vector_type(2))); typedef __bf16 bf16x2_t __attribute__((ext_vector_type(2)));
__device__ __forceinline__ unsigned cvtpk_s(float lo, float hi) { f32x2_t v = {lo, hi}; bf16x2_t b = __builtin_convertvector(v, bf16x2_t); return __builtin_bit_cast(unsigned, b); }
#define WAIT_BAR(N) asm volatile("s_waitcnt vmcnt(" #N ") lgkmcnt(0)\n\ts_barrier" ::: "memory")

__device__ __forceinline__ void qkt(f32x16& p0, f32x16& p1, const char* Kslot, const bf16x8* qr, const f32x16& negm, int r32, int hi) {
    const char* kb = Kslot + hi * 1024 + r32 * 16;
#pragma unroll
    for (int d0 = 0; d0 < 4; ++d0) {
        const bf16x8 b0 = *reinterpret_cast<const bf16x8*>(kb + d0 * 2048);
        const bf16x8 b1 = *reinterpret_cast<const bf16x8*>(kb + d0 * 2048 + 512);
        if (d0 == 0) { p0 = __builtin_amdgcn_mfma_f32_32x32x16_bf16(b0, qr[0], negm, 0, 0, 0); p1 = __builtin_amdgcn_mfma_f32_32x32x16_bf16(b1, qr[0], negm, 0, 0, 0); }
        else { p0 = __builtin_amdgcn_mfma_f32_32x32x16_bf16(b0, qr[d0], p0, 0, 0, 0); p1 = __builtin_amdgcn_mfma_f32_32x32x16_bf16(b1, qr[d0], p1, 0, 0, 0); } }
}
typedef __attribute__((address_space(3))) const char* lds_cptr;
typedef short v4i16_t __attribute__((ext_vector_type(4)));
__device__ __forceinline__ void kload8(bf16x8* kf, lds_cptr kp) {
    kf[0] = *(const LAS bf16x8*)(kp);        kf[1] = *(const LAS bf16x8*)(kp + 512);
    kf[2] = *(const LAS bf16x8*)(kp + 2048); kf[3] = *(const LAS bf16x8*)(kp + 2560);
    kf[4] = *(const LAS bf16x8*)(kp + 4096); kf[5] = *(const LAS bf16x8*)(kp + 4608);
    kf[6] = *(const LAS bf16x8*)(kp + 6144); kf[7] = *(const LAS bf16x8*)(kp + 6656);
}
__device__ __forceinline__ void kload2(bf16x8* kf, lds_cptr kp, int j) { kf[2 * j] = *(const LAS bf16x8*)(kp + j * 2048); kf[2 * j + 1] = *(const LAS bf16x8*)(kp + j * 2048 + 512); }
__device__ __forceinline__ s16x4 vtr(lds_cptr p) { return __builtin_bit_cast(s16x4, __builtin_amdgcn_ds_read_tr16_b64_v4i16((LAS v4i16_t*)p)); }
__device__ __forceinline__ float rowmax(const f32x16& p0, const f32x16& p1) {
    float a = max3f(p0[0], p0[1], p1[0]), b = max3f(p0[2], p0[3], p1[1]); a = max3f(a, p1[2], p1[3]);
#pragma unroll
    for (int r = 4; r < 16; r += 4) { a = max3f(a, p0[r], p0[r + 1]); b = max3f(b, p0[r + 2], p0[r + 3]); a = max3f(a, p1[r], p1[r + 1]); b = max3f(b, p1[r + 2], p1[r + 3]); }
    const float m = max2f(a, b);
    auto rr = __builtin_amdgcn_permlane32_swap(__float_as_uint(m), __float_as_uint(m), false, false);
    return max2f(__uint_as_float(rr[0]), __uint_as_float(rr[1]));
}
__device__ __forceinline__ void pv(f32x16* o, int vb, bf16x8 pa0, bf16x8 pa1, bf16x8 pa2, bf16x8 pa3) {
#pragma unroll
    for (int d0 = 0; d0 < 2; ++d0) { s16x4 lo[4], hi[4];
#pragma unroll
        for (int ks = 0; ks < 4; ++ks) {
            asm volatile("ds_read_b64_tr_b16 %0,%1 offset:%c2" : "=&v"(lo[ks]) : "v"(vb), "i"(d0 * 4096 + ks * 1024) : "memory");
            asm volatile("ds_read_b64_tr_b16 %0,%1 offset:%c2" : "=&v"(hi[ks]) : "v"(vb), "i"(d0 * 4096 + ks * 1024 + 512) : "memory"); }
        asm volatile("s_waitcnt lgkmcnt(0)" ::: "memory"); SBAR();
#define PK(k) (bf16x8){lo[k][0], lo[k][1], lo[k][2], lo[k][3], hi[k][0], hi[k][1], hi[k][2], hi[k][3]}
        o[d0] = __builtin_amdgcn_mfma_f32_32x32x16_bf16(pa0, PK(0), o[d0], 0, 0, 0);
        o[d0] = __builtin_amdgcn_mfma_f32_32x32x16_bf16(pa1, PK(1), o[d0], 0, 0, 0);
        o[d0] = __builtin_amdgcn_mfma_f32_32x32x16_bf16(pa2, PK(2), o[d0], 0, 0, 0);
        o[d0] = __builtin_amdgcn_mfma_f32_32x32x16_bf16(pa3, PK(3), o[d0], 0, 0, 0);
#undef PK
    }
}

template <int THRL, bool DRY> __device__ __forceinline__ void attn_unit(int b, int h, int qb, const bf16* Q, const bf16* __restrict__ K, const bf16* __restrict__ V, const bf16* __restrict__ KL, const bf16* __restrict__ VL, bf16* O, const float* __restrict__ C2, char* shm) {
    int tid_ = threadIdx.x; asm volatile("" : "+v"(tid_));
    const int tid = tid_, lane = tid & 63, r32 = lane & 31, hi = lane >> 5; const int wid = __builtin_amdgcn_readfirstlane(tid >> 6);
    const long rowbase = (long)b * PP; const int q0 = 128 + qb * QB;
    const bf16* Qw = Q + (rowbase + q0 + wid * QBLK) * DM + h * D;
    const bf16* Kh = K + (rowbase + 64) * DM + h * D, *Vh = V + (rowbase + 64) * DM + h * D;
    const unsigned lds0 = (unsigned)(uintptr_t)shm;
    float* wsf = (float*)(shm + LDS_WS) + wid * 64;
    const int NT = 6 + 4 * qb, NTR = NT - 1;
    const lds_cptr shm3 = (lds_cptr)shm;
    const float* c2g = C2 + ((size_t)(b * 16 + h)) * PP + 64;
    { LAS float* c2w = (LAS float*)(shm3 + LDS_C2); LAS float* c2tw = (LAS float*)(shm3 + LDS_C2T);
      for (int i = tid; i < 64 * NT; i += 512) c2w[i] = (i < 64 * NTR) ? (c2g[i] - c2g[i | 63]) : 0.f;
      if (tid < NT) c2tw[tid] = (tid < NTR) ? c2g[64 * tid + 63] : 0.f; }
    const float c2q = c2g[q0 - 64 + wid * QBLK + r32];
    const LAS float* c2s = (const LAS float*)(shm3 + LDS_C2) + 4 * hi;
    const LAS float* c2t = (const LAS float*)(shm3 + LDS_C2T);
    const bf16* ksrc = Kh + (long)lane * DM + wid * 8;
    const bf16* vsrc = Vh + (long)(16 * (wid & 3) + (lane >> 2)) * DM + (wid >> 2) * 32 + (lane & 3) * 8;
    const unsigned kdst = lds0 + LDS_K + wid * 1024, vdst = lds0 + LDS_V + wid * 1024;
#define TCL(t) (((t) < NTR) ? (t) : (NTR - 1))
#define DMA_K(t, slot) glds16(ksrc + (long)TCL(t) * KVBLK * DM, (unsigned)__builtin_amdgcn_readfirstlane(kdst + (slot)))
#define DMA_V(t, slot) glds16(vsrc + (long)TCL(t) * KVBLK * DM, (unsigned)__builtin_amdgcn_readfirstlane(vdst + (slot)))
    const int vb0 = (int)(lds0 + LDS_V) + ((lane >> 4) & 1) * 32 + (lane & 3) * 8 + (4 * hi + ((lane & 15) >> 2)) * 64;
    const char* Kbase = shm + LDS_K; bf16x8 kf[8];
    const lds_cptr kp0 = shm3 + LDS_K + hi * 1024 + r32 * 16; const lds_cptr vp0 = shm3 + LDS_V + ((lane >> 4) & 1) * 32 + (lane & 3) * 8 + (4 * hi + ((lane & 15) >> 2)) * 64;
    glds16(KL + (long)(64 + lane) * DM + h * D + wid * 8, (unsigned)__builtin_amdgcn_readfirstlane(kdst));
    glds16(VL + (long)(64 + 16 * (wid & 3) + (lane >> 2)) * DM + h * D + (wid >> 2) * 32 + (lane & 3) * 8, (unsigned)__builtin_amdgcn_readfirstlane(vdst));
    DMA_K(1, SLOTB);
    bf16x8 qr[4];
#pragma unroll
    for (int d0 = 0; d0 < 4; ++d0) qr[d0] = *reinterpret_cast<const bf16x8*>(&Qw[(long)r32 * DM + d0 * 16 + hi * 8]);
    float l_reg = 0.f; f32x16 o[2]; o[0] = f32x16{}; o[1] = f32x16{}; const f32x16 negm = f32x16{}; float moff = 0.f, mq = 0.f;
    const int qrel = wid * QBLK + r32;
#define CMASK(P0, P1, t) do { int jb_ = (t) - (NT - 5); if (jb_ >= 0) cmask(P0, P1, jb_, qrel, hi); } while (0)
    bool resc = false;
#define EXD(P, OFF) do { _Pragma("unroll") for (int g_ = 0; g_ < 4; ++g_) { const f32x4 dk_ = *(const LAS f32x4*)(c2s + (OFF) + 8 * g_); \
      _Pragma("unroll") for (int i_ = 0; i_ < 4; ++i_) P[4 * g_ + i_] = __builtin_amdgcn_exp2f((P[4 * g_ + i_] - moff) - dk_[i_]); } } while (0)
#define START(P0, P1) do { const float rmr = rowmax(P0, P1); resc = false; \
    mq = rmr - c2t[0]; moff = rmr; \
    EXD(P0, 0); } while (0)
#define RESC() do { if (resc) { asm volatile("s_waitcnt lgkmcnt(0)" ::: "memory"); \
      _Pragma("unroll") for (int d_ = 0; d_ < 2; ++d_) _Pragma("unroll") for (int r = 0; r < 16; ++r) o[d_][r] *= wsf[crow(r, hi)]; } } while (0)
    f32x16 pA0, pA1, pB0, pB1;
    int sl_prev = 0, sl_cur = 0, sl_next = SLOTB;
#define ROT() do { sl_prev = sl_cur; sl_cur = sl_next; sl_next = (sl_next == (NSLOT - 1) * SLOTB) ? 0 : sl_next + SLOTB; } while (0)
    DMA_K(2, 2 * SLOTB);
    WAIT_BAR(3);
    qkt(pA0, pA1, Kbase, qr, negm, r32, hi); asm volatile("s_nop 15\n\ts_nop 7" : "+v"(pA0), "+v"(pA1)); CMASK(pA0, pA1, 0);
    START(pA0, pA1);
    EXD(pA1, 32);
    WAIT_BAR(0);
    DMA_K(3, 0); DMA_V(1, SLOTB);
    ROT();
    kload8(kf, kp0 + sl_cur);
    WAIT_BAR(2);
    s16x4 vlo[8], vhi[8]; u32x4 pw0, pw1, pw2, pw3;
#define PKW(P, B) cvtpk_s(P[B], P[B + 1])
#define PAF(k) __builtin_bit_cast(bf16x8, pw##k)
#define VFR(i) (bf16x8){vlo[i][0], vlo[i][1], vlo[i][2], vlo[i][3], vhi[i][0], vhi[i][1], vhi[i][2], vhi[i][3]}
#define PIN(x) asm volatile("" : "+v"(x))
#define MX3(a, b, c) __builtin_fmaxf(__builtin_fmaxf((a), (b)), (c))
#define GAPA(MF, A0, A1, A2, A3, W0, W1, PW) do { MF; sacc += A0; sacc += A1; sacc += A2; sacc += A3; PIN(sacc); W0; W1; PIN(PW); SBAR(); } while (0)
#define EX(v) __builtin_amdgcn_exp2f(v)
#define DKR(OFF) (*(const LAS f32x4*)(dkp_ + (OFF)))
#define GAPB(MF, X, B, DKC, DKN, OFFN) do { MF; DKN = DKR(OFFN); X[B] = EX((X[B] - moff) - DKC[0]); X[B + 1] = EX((X[B + 1] - moff) - DKC[1]); X[B + 2] = EX((X[B + 2] - moff) - DKC[2]); X[B + 3] = EX((X[B + 3] - moff) - DKC[3]); PIN(X); SBAR(); } while (0)
#define VRD(i) do { vlo[i] = vtr(vp_ + (((i) >> 2) * 4096 + ((i) & 3) * 1024)); vhi[i] = vtr(vp_ + (((i) >> 2) * 4096 + ((i) & 3) * 1024 + 512)); } while (0)
#define KRD(G, j) do { if (G) { kload2(kf, kp0 + sl_next, j); SBAR(); } } while (0)
#define STEP(C0, C1, P0, P1, t, GK, GV, GL) do { SBAR(); \
    const lds_cptr vp_ = vp0 + sl_prev; \
    VRD(0); SBAR(); float sacc = (P0[0] + P0[1]); \
    GAPA(C0 = __builtin_amdgcn_mfma_f32_32x32x16_bf16(kf[0], qr[0], negm, 0, 0, 0), P0[2], P0[3], P0[4], P0[5],     pw0[0] = PKW(P0, 0), pw0[1] = PKW(P0, 2), pw0); \
    VRD(4); SBAR(); GAPA(C1 = __builtin_amdgcn_mfma_f32_32x32x16_bf16(kf[1], qr[0], negm, 0, 0, 0), P0[6], P0[7], P0[8], P0[9],     pw0[2] = PKW(P0, 4), pw0[3] = PKW(P0, 6), pw0); \
    VRD(1); SBAR(); GAPA(C0 = __builtin_amdgcn_mfma_f32_32x32x16_bf16(kf[2], qr[1], C0, 0, 0, 0),   P0[10], P0[11], P0[12], P0[13], pw1[0] = PKW(P0, 8), pw1[1] = PKW(P0, 10), pw1); \
    VRD(5); SBAR(); GAPA(C1 = __builtin_amdgcn_mfma_f32_32x32x16_bf16(kf[3], qr[1], C1, 0, 0, 0),   P0[14], P0[15], P1[0], P1[1],   pw1[2] = PKW(P0, 12), pw1[3] = PKW(P0, 14), pw1); \
    VRD(2); SBAR(); GAPA(C0 = __builtin_amdgcn_mfma_f32_32x32x16_bf16(kf[4], qr[2], C0, 0, 0, 0),   P1[2], P1[3], P1[4], P1[5],     pw2[0] = PKW(P1, 0), pw2[1] = PKW(P1, 2), pw2); \
    VRD(6); SBAR(); GAPA(C1 = __builtin_amdgcn_mfma_f32_32x32x16_bf16(kf[5], qr[2], C1, 0, 0, 0),   P1[6], P1[7], P1[8], P1[9],     pw2[2] = PKW(P1, 4), pw2[3] = PKW(P1, 6), pw2); \
    VRD(3); SBAR(); GAPA(C0 = __builtin_amdgcn_mfma_f32_32x32x16_bf16(kf[6], qr[3], C0, 0, 0, 0),   P1[10], P1[11], P1[12], P1[13], pw3[0] = PKW(P1, 8), pw3[1] = PKW(P1, 10), pw3); \
    VRD(7); SBAR(); GAPA(C1 = __builtin_amdgcn_mfma_f32_32x32x16_bf16(kf[7], qr[3], C1, 0, 0, 0),   P1[14], P1[15], 0.f, 0.f,       pw3[2] = PKW(P1, 12), pw3[3] = PKW(P1, 14), pw3); \
    l_reg += sacc; \
    if (GK) { DMA_K((t) + 3, sl_cur); } if (GV) { DMA_V((t) + 1, sl_next); } \
    CMASK(C0, C1, t); \
    const LAS float* dkp_ = c2s + 64 * (t); f32x4 dkA_ = DKR(0), dkB_; \
    { float a = MX3(C0[0], C0[1], C1[0]), b = MX3(C0[2], C0[3], C1[1]); a = MX3(a, C1[2], C1[3]); \
      _Pragma("unroll") for (int r = 4; r < 16; r += 4) { a = MX3(a, C0[r], C0[r + 1]); b = MX3(b, C0[r + 2], C0[r + 3]); a = MX3(a, C1[r], C1[r + 1]); b = MX3(b, C1[r + 2], C1[r + 3]); } \
      float rm = __builtin_fmaxf(a, b); { auto rr = __builtin_amdgcn_permlane32_swap(__float_as_uint(rm), __float_as_uint(rm), false, false); rm = __builtin_fmaxf(__uint_as_float(rr[0]), __uint_as_float(rr[1])); } \
      moff = mq + c2t[t]; rm -= moff; \
      resc = false; \
      if (__builtin_expect(__any(rm > (float)THRL), 0)) { const float dl = __builtin_fmaxf(rm, 0.f); mq += dl; moff += dl; \
        const float f = __builtin_amdgcn_exp2f(-dl); l_reg *= f; if (hi == 0) wsf[r32] = f; resc = true; } } \
    SBAR(); \
    GAPB(o[0] = __builtin_amdgcn_mfma_f32_32x32x16_bf16(PAF(0), VFR(0), o[0], 0, 0, 0), C0, 0, dkA_, dkB_, 8); \
    GAPB(o[1] = __builtin_amdgcn_mfma_f32_32x32x16_bf16(PAF(0), VFR(4), o[1], 0, 0, 0), C0, 4, dkB_, dkA_, 16); \
    KRD(GL, 0); GAPB(o[0] = __builtin_amdgcn_mfma_f32_32x32x16_bf16(PAF(1), VFR(1), o[0], 0, 0, 0), C0, 8, dkA_, dkB_, 24); \
    KRD(GL, 1); GAPB(o[1] = __builtin_amdgcn_mfma_f32_32x32x16_bf16(PAF(1), VFR(5), o[1], 0, 0, 0), C0, 12, dkB_, dkA_, 32); \
    KRD(GL, 2); GAPB(o[0] = __builtin_amdgcn_mfma_f32_32x32x16_bf16(PAF(2), VFR(2), o[0], 0, 0, 0), C1, 0, dkA_, dkB_, 40); \
    KRD(GL, 3); GAPB(o[1] = __builtin_amdgcn_mfma_f32_32x32x16_bf16(PAF(2), VFR(6), o[1], 0, 0, 0), C1, 4, dkB_, dkA_, 48); \
    GAPB(o[0] = __builtin_amdgcn_mfma_f32_32x32x16_bf16(PAF(3), VFR(3), o[0], 0, 0, 0), C1, 8, dkA_, dkB_, 56); \
    GAPB(o[1] = __builtin_amdgcn_mfma_f32_32x32x16_bf16(PAF(3), VFR(7), o[1], 0, 0, 0), C1, 12, dkB_, dkA_, 56); \
    } while (0)
    int t = 1;
#undef CMASK
#define CMASK(P0, P1, t) do { } while (0)
    for (; t + 6 < NT; t += 2) {
        STEP(pB0, pB1, pA0, pA1, t, true, true, true);     WAIT_BAR(2); RESC(); ROT();
        STEP(pA0, pA1, pB0, pB1, t + 1, true, true, true); WAIT_BAR(2); RESC(); ROT();
    }
#undef CMASK
#define CMASK(P0, P1, t) do { int jb_ = (t) - (NT - 5); if (jb_ >= 0) cmask(P0, P1, jb_, qrel, hi); } while (0)
#define ENDW(tt) do { if ((tt) + 3 < NT) { WAIT_BAR(2); } else if ((tt) + 2 < NT) { WAIT_BAR(1); } else { WAIT_BAR(0); } } while (0)
    for (; t + 1 < NT; t += 2) {
        STEP(pB0, pB1, pA0, pA1, t, (t + 3 < NT), (t + 1 < NT), (t + 1 < NT));         ENDW(t);     RESC(); ROT();
        STEP(pA0, pA1, pB0, pB1, t + 1, (t + 4 < NT), (t + 2 < NT), (t + 2 < NT));     ENDW(t + 1); RESC(); ROT();
    }
    STEP(pB0, pB1, pA0, pA1, NT - 1, false, false, false); RESC();
    { float sacc = pB0[0] + pB0[1]; _Pragma("unroll") for (int r = 2; r < 16; ++r) sacc += pB0[r]; _Pragma("unroll") for (int r = 0; r < 16; ++r) sacc += pB1[r]; l_reg += sacc;
      pw0 = (u32x4){PKW(pB0, 0), PKW(pB0, 2), PKW(pB0, 4), PKW(pB0, 6)}; pw1 = (u32x4){PKW(pB0, 8), PKW(pB0, 10), PKW(pB0, 12), PKW(pB0, 14)}; pw2 = (u32x4){PKW(pB1, 0), PKW(pB1, 2), PKW(pB1, 4), PKW(pB1, 6)}; pw3 = (u32x4){PKW(pB1, 8), PKW(pB1, 10), PKW(pB1, 12), PKW(pB1, 14)};
      SBAR(); pv(o, vb0 + sl_cur, PAF(0), PAF(1), PAF(2), PAF(3)); }
#undef PKW
#undef PAF
#undef VFR
#undef PIN
#undef MX3
#undef GAPA
#undef GAPB
#undef EX
#undef DKR
#undef VRD
#undef KRD
#undef STEP
#undef ENDW
    { auto rr = __builtin_amdgcn_permlane32_swap(__float_as_uint(l_reg), __float_as_uint(l_reg), false, false); l_reg = __uint_as_float(rr[0]) + __uint_as_float(rr[1]); }
    if (hi == 0) wsf[32 + r32] = l_reg; asm volatile("s_waitcnt lgkmcnt(0)" ::: "memory");
    float rli[16];
#pragma unroll
    for (int r = 0; r < 16; ++r) rli[r] = __builtin_amdgcn_rcpf(wsf[32 + crow(r, hi)]);
    bf16* Ow = O + (rowbase + q0 + wid * QBLK) * DM + h * D;
    { bf16* stg = (bf16*)(shm + LDS_OST) + wid * 2048;
#pragma unroll
      for (int r = 0; r < 16; ++r) { const int orow = crow(r, hi);
#pragma unroll
        for (int d0 = 0; d0 < 2; ++d0) stg[orow * 64 + d0 * 32 + r32] = __float2bfloat16(o[d0][r] * rli[r]); }
      asm volatile("s_waitcnt lgkmcnt(0)" ::: "memory");
#pragma unroll
      for (int i = 0; i < 4; ++i) { const int row = i * 8 + (lane >> 3), ch = lane & 7; const u32x4 v = *(const u32x4*)(stg + row * 64 + ch * 8); if (!DRY || v.x == 0x12345679u) *(u32x4*)(Ow + (long)row * DM + ch * 8) = v; } }
    asm volatile("s_waitcnt lgkmcnt(0)\n\ts_barrier" ::: "memory");
#undef DMA_K
#undef DMA_V
#undef TCL
#undef CMASK
#undef EXD
#undef START
#undef RESC
#undef ROT
}
#undef SBAR
#undef WAIT_BAR
}

constexpr int RING_BYTES = 131072;
constexpr int LDS_BYTES = 147456;

__device__ __forceinline__ void tr_item(const float* W, int ldw, int K, int k0, int nvalid, const float* gain, bf16_t* dst, LAS float* scr, int lane) {
    float tv[32];
#pragma unroll
    for (int i = 0; i < 32; ++i) { const int kk = 2 * i + (lane >> 5), c = lane & 31; tv[i] = (c < nvalid) ? W[(size_t)(k0 + kk) * ldw + c] : 0.f; }
#pragma unroll
    for (int i = 0; i < 32; ++i) { const int kk = 2 * i + (lane >> 5), c = lane & 31; float v = tv[i]; if (gain) v *= gain[k0 + kk]; scr[kk * 33 + c] = v; }
    LDS_WAIT(); asm volatile("" ::: "memory");
    const int c8 = lane & 7;
#pragma unroll
    for (int j = 0; j < 4; ++j) { const int n = (lane >> 3) + 8 * j; const LAS float* s = scr + (8 * c8) * 33 + n;
        u32x4 o; o.x = cvt_pk_bf16(s[0 * 33], s[1 * 33]); o.y = cvt_pk_bf16(s[2 * 33], s[3 * 33]); o.z = cvt_pk_bf16(s[4 * 33], s[5 * 33]); o.w = cvt_pk_bf16(s[6 * 33], s[7 * 33]);
        *(u32x4*)(dst + (size_t)n * K + k0 + 8 * c8) = o; }
    LDS_WAIT(); asm volatile("" ::: "memory");
}
enum MapMode { MAP_ID = 0, MAP_SWA, MAP_SWB, MAP_H64, MAP_ROT };
__device__ __forceinline__ int map_row(int mode, int nb) {
    const int c = 32 * nb;
    switch (mode) {
        case MAP_SWA: return 256 * (c >> 7) + (c & 127);
        case MAP_SWB: return 256 * (c >> 7) + 128 + (c & 127);
        case MAP_H64: { const int tl = c >> 8, ob = (c & 255) >> 5; return 256 * tl + 128 * (ob & 1) + 32 * (ob >> 1); }
        case MAP_ROT: { const int tl = c >> 8, ob = (c & 255) >> 5; return 256 * tl + 128 * ((ob >> 1) & 1) + 64 * (ob >> 2) + 32 * (ob & 1); }
        default: return c;
    }
}
struct Seg { const float* W; int ldw, K, ncols; const float* gain; size_t dst; int dstrow, mode; };
__device__ __forceinline__ Seg get_seg(const Params& p, int s) {
    switch (s) {
        case 0: return Seg{p.w1i, 2 * DFF, 1024, DFF, p.n1, WS_W1A, 0, MAP_SWA};
        case 1: return Seg{p.w1i + DFF, 2 * DFF, 1024, DFF, p.n1, WS_W1A, 0, MAP_SWB};
        case 2: return Seg{p.w1o, 1024, DFF, 1024, nullptr, WS_W1B, 0, MAP_ID};
        case 3: return Seg{p.win + 0, NINC, 1024, 1024, p.nm, WS_WIN, WIN_FOX, MAP_H64};
        case 4: return Seg{p.win + 1024, NINC, 1024, 1024, p.nm, WS_WIN, WIN_FOX + 1024, MAP_H64};
        case 5: return Seg{p.win + 2048, NINC, 1024, 1024, p.nm, WS_WIN, WIN_FOX + 2048, MAP_ID};
        case 6: return Seg{p.win + 3072, NINC, 1024, 16, p.nm, WS_WIN, WIN_RET + 3072, MAP_ID};
        case 7: return Seg{p.win + 3088, NINC, 1024, 512, p.nm, WS_WIN, WIN_RET + 0, MAP_ROT};
        case 8: return Seg{p.win + 3600, NINC, 1024, 512, p.nm, WS_WIN, WIN_RET + 512, MAP_ROT};
        case 9: return Seg{p.win + 4112, NINC, 1024, 1024, p.nm, WS_WIN, WIN_RET + 1024, MAP_ID};
        case 10: return Seg{p.win + 5136, NINC, 1024, 1024, p.nm, WS_WIN, WIN_RET + 2048, MAP_ID};
        case 11: return Seg{p.win + 6160, NINC, 1024, 1024, p.nm, WS_WIN, WIN_GA, MAP_ID};
        case 12: return Seg{p.win + 7184, NINC, 1024, 1024, p.nm, WS_WIN, WIN_GB, MAP_ID};
        case 13: return Seg{p.wof, 1024, 1024, 1024, nullptr, WS_WOF, 0, MAP_ID};
        case 14: return Seg{p.wor, 1024, 1024, 1024, nullptr, WS_WOR, 0, MAP_ID};
        case 15: return Seg{p.wout, 1024, 1024, 1024, nullptr, WS_WOUT, 0, MAP_ID};
        case 16: return Seg{p.w2i, 2 * DFF, 1024, DFF, p.n2, WS_W2A, 0, MAP_SWA};
        case 17: return Seg{p.w2i + DFF, 2 * DFF, 1024, DFF, p.n2, WS_W2A, 0, MAP_SWB};
        default: return Seg{p.w2o, 1024, DFF, 1024, nullptr, WS_W2B, 0, MAP_ID};
    }
}
__device__ __forceinline__ int seg_items(int s) {
    switch (s) {
        case 0: case 1: case 16: case 17: return 16 * 88;
        case 2: case 18: return 44 * 32;
        case 6: return 16;
        case 7: case 8: return 16 * 16;
        default: return 16 * 32;
    }
}
__device__ __forceinline__ void convert_range(const Params& p, LAS float* scr, int s_lo, int s_hi, int worker, int nworkers, int lane) {
    int total = 0;
#pragma unroll 1
    for (int s = s_lo; s <= s_hi; ++s) total += seg_items(s);
#pragma unroll 1
    for (int it = worker; it < total; it += nworkers) {
        int r = it, s = s_lo;
        while (r >= seg_items(s)) { r -= seg_items(s); ++s; }
        const Seg sg = get_seg(p, s);
        const int nblk = (sg.ncols + 31) / 32, kb = r / nblk, nb = r % nblk;
        const int nvalid = sg.ncols - 32 * nb < 32 ? sg.ncols - 32 * nb : 32;
        bf16_t* dst = (bf16_t*)(p.ws + sg.dst) + (size_t)(sg.dstrow + map_row(sg.mode, nb)) * sg.K;
        tr_item(sg.W + 32 * nb, sg.ldw, sg.K, 64 * kb, nvalid, sg.gain, dst, scr, lane);
    }
}
__device__ __forceinline__ void p0_prologue(const KP kp_, LAS unsigned char* lds, int vcu, int G, int tid, int wid, int lane) {
    const Params p = ldp(kp_);
    LAS float* scr = (LAS float*)(lds + wid * 16384);
    const int gw = vcu * 8 + wid, NGW = G * 8;
    convert_range(p, scr, 0, 1, gw, NGW, lane);
    { u32x4* z = (u32x4*)((bf16_t*)(p.ws + WS_WIN) + (size_t)(WIN_RET + 3072 + 32) * 1024); const int nz = 224 * 1024 * 2 / 16;
      for (int i = (vcu * 512 + tid); i < nz; i += G * 512) z[i] = (u32x4){0u, 0u, 0u, 0u}; }
    { bf16_t* XB = (bf16_t*)(p.ws + WS_XB); float* S0 = (float*)(p.ws + WS_SSQ0);
      for (int row0 = gw; row0 < MP; row0 += 2 * NGW) {
        f32x4 v[2][4]; float s[2];
#pragma unroll
        for (int h = 0; h < 2; ++h) { const int row = row0 + h * NGW; const int b = row / PP, pidx = row - b * PP;
#pragma unroll
            for (int j = 0; j < 4; ++j) { v[h][j] = (f32x4){0.f, 0.f, 0.f, 0.f};
                if (row < MP) { if (pidx >= 128) v[h][j] = *((const f32x4*)(p.x + ((size_t)(b * SEQ + pidx - 128)) * DM) + lane + 64 * j);
                    else if (pidx >= 112) v[h][j] = *((const f32x4*)(p.meta + (size_t)(pidx - 112) * DM) + lane + 64 * j); } } }
#pragma unroll
        for (int h = 0; h < 2; ++h) { s[h] = 0.f;
#pragma unroll
            for (int j = 0; j < 4; ++j) s[h] += (v[h][j][0] * v[h][j][0] + v[h][j][1] * v[h][j][1]) + (v[h][j][2] * v[h][j][2] + v[h][j][3] * v[h][j][3]);
            s[h] = wave_sum(s[h]); }
#pragma unroll
        for (int h = 0; h < 2; ++h) { const int row = row0 + h * NGW; if (row < MP) {
            u32x2* o8 = (u32x2*)(XB + (size_t)row * DM) + lane;
#pragma unroll
            for (int j = 0; j < 4; ++j) o8[64 * j] = pack4(v[h][j]);
            if (lane < 16) S0[(size_t)row * 16 + lane] = (lane == 0) ? s[h] : 0.f; } } } }
    { float* S1 = (float*)(p.ws + WS_SSQ1); for (int i = vcu * 512 + tid; i < NB * 2048; i += G * 512) S1[(size_t)(i >> 11) * PP * 16 + (i & 2047)] = 0.f; }
    { float* COS = (float*)(p.ws + WS_COS); float* SIN = (float*)(p.ws + WS_SIN);
      for (int i = vcu * 512 + tid; i < PP * 64; i += G * 512) { const int pidx = i >> 6, fi = i & 63;
        const float inv = exp2f(-(float)fi * (13.287712379549449f / 64.0f));
        const float ang = (float)(pidx - 112) * inv;
        const double a = (double)ang; const double kq = rint(a * 0.15915494309189535); const float red = (float)(a - kq * 6.283185307179586);
        COS[i] = __cosf(red); SIN[i] = __sinf(red); } }
}

__device__ __forceinline__ void thin_g2(const KP kp_, LAS unsigned char* lds, int bx, int wid, int lane) {
    if (bx >= 64) return;
    const Params p = ldp(kp_);
    const int l15 = lane & 15, g = lane >> 4, tile = bx, n0 = tile * 16;
    const bf16_t* wp = (const bf16_t*)(p.ws + WS_W1B) + (size_t)(n0 + l15) * DFF + 352 * wid + 8 * g;
    const bf16_t* hp = (const bf16_t*)(p.ws + WS_HID) + (size_t)(112 + l15) * DFF + 352 * wid + 8 * g;
    f32x4 acc = (f32x4){0.f, 0.f, 0.f, 0.f};
    bf16x8 a[11], b[11];
#pragma unroll
    for (int i = 0; i < 11; ++i) { a[i] = *(const bf16x8*)(wp + 32 * i); b[i] = *(const bf16x8*)(hp + 32 * i); }
#pragma unroll
    for (int i = 0; i < 11; ++i) acc = __builtin_amdgcn_mfma_f32_16x16x32_bf16(a[i], b[i], acc, 0, 0, 0);
    LAS f32x4* part = (LAS f32x4*)lds;
    part[wid * 64 + lane] = acc;
    __syncthreads();
    if (wid == 0) {
#pragma unroll
        for (int w = 1; w < 8; ++w) acc += part[w * 64 + lane];
        const f32x4 base = *(const f32x4*)(p.meta + (size_t)l15 * DM + n0 + 4 * g);
        const f32x4 h = base + acc * 0.5f;
        float ss = (h[0] * h[0] + h[1] * h[1]) + (h[2] * h[2] + h[3] * h[3]);
        ss += __shfl_xor(ss, 16); ss += __shfl_xor(ss, 32);
        bf16_t* HB = (bf16_t*)(p.ws + WS_XB); float* S1 = (float*)(p.ws + WS_SSQ1);
#pragma unroll
        for (int bb = 0; bb < NB; ++bb) { const size_t row = (size_t)bb * PP + 112 + l15;
            *(u32x2*)(HB + row * DM + n0 + 4 * g) = pack4(h);
            if (g == 0) atomicAdd(S1 + row * 16 + (tile & 15), ss); }
    }
    __syncthreads();
}

__device__ __forceinline__ float lg2gamma(int hd) { return log2f(1.0f - exp2f(-5.0f - (float)hd)); }
__device__ __forceinline__ void ret_kv_phase(const KP kp_, int vcu, int G, int wid, int lane) {
    const Params p = ldp(kp_);
    const bf16_t* KT = (const bf16_t*)(p.ws + WS_KT); const bf16_t* VT = (const bf16_t*)(p.ws + WS_VT); bf16_t* KVR = (bf16_t*)(p.ws + WS_KVR);
    const int l15 = lane & 15, g = lane >> 4;
#pragma unroll 1
    for (int u = vcu; u < 16 * 32; u += G) {
        const int bh = u >> 5, c = u & 31, hd = bh & 3; const float lg = lg2gamma(hd);
        const int bhs = (c == 0) ? hd : bh;
        f32x4 acc[2][8];
#pragma unroll
        for (int a = 0; a < 2; ++a)
#pragma unroll
            for (int b = 0; b < 8; ++b) acc[a][b] = (f32x4){0.f, 0.f, 0.f, 0.f};
#pragma unroll 1
        for (int s = 0; s < 4; ++s) {
            const int ml = 32 * s + 8 * g, m0 = 128 * c + ml;
            bf16x8 a[2]; u32x4 raw[2]; bf16x8 bfr[8];
#pragma unroll
            for (int ti = 0; ti < 2; ++ti) raw[ti] = *(const u32x4*)(VT + ((size_t)(bhs * 256 + 32 * wid + 16 * ti + l15)) * PP + m0);
#pragma unroll
            for (int tj = 0; tj < 8; ++tj) bfr[tj] = *(const bf16x8*)(KT + ((size_t)(bhs * 128 + 16 * tj + l15)) * PP + m0);
            asm volatile("" ::: "memory");
            float z[8];
#pragma unroll
            for (int j = 0; j < 8; ++j) z[j] = exp2f(lg * (float)(127 - (ml + j)));
#pragma unroll
            for (int ti = 0; ti < 2; ++ti) { u32x4 w; w.x = cvt_pk_bf16(bf_lo(raw[ti].x) * z[0], bf_hi(raw[ti].x) * z[1]); w.y = cvt_pk_bf16(bf_lo(raw[ti].y) * z[2], bf_hi(raw[ti].y) * z[3]);
                w.z = cvt_pk_bf16(bf_lo(raw[ti].z) * z[4], bf_hi(raw[ti].z) * z[5]); w.w = cvt_pk_bf16(bf_lo(raw[ti].w) * z[6], bf_hi(raw[ti].w) * z[7]);
                a[ti] = __builtin_bit_cast(bf16x8, w); }
#pragma unroll
            for (int tj = 0; tj < 8; ++tj) {
                acc[0][tj] = __builtin_amdgcn_mfma_f32_16x16x32_bf16(bfr[tj], a[0], acc[0][tj], 0, 0, 0);
                acc[1][tj] = __builtin_amdgcn_mfma_f32_16x16x32_bf16(bfr[tj], a[1], acc[1][tj], 0, 0, 0); }
        }
        bf16_t* o = KVR + ((size_t)(bh * 33 + c)) * 32768;
#pragma unroll
        for (int ti = 0; ti < 2; ++ti)
#pragma unroll
            for (int tj = 0; tj < 8; ++tj) *(u32x2*)(o + (size_t)(32 * wid + 16 * ti + l15) * 128 + 16 * tj + 4 * g) = pack4(acc[ti][tj]);
    }
}
__device__ __forceinline__ void cumsum_phase(const KP kp_, LAS unsigned char* lds, int vcu, int G, int wid, int lane) {
    const Params p = ldp(kp_);
    const float* LF = (const float*)(p.ws + WS_LOGF);
    LAS float* tot = (LAS float*)lds;
#pragma unroll 1
    for (int sq = vcu; sq < 64; sq += G) {
        const float* base = LF + (size_t)sq * PP; const float* base0 = LF + (size_t)(sq & 15) * PP; float* outp = (float*)(p.ws + WS_C2) + (size_t)sq * PP;
        const int cs = (wid * 66) >> 3, ce = ((wid + 1) * 66) >> 3;
        float inc[9]; float carry = 0.f;
#pragma unroll
        for (int k = 0; k < 9; ++k) { const int i = cs + k; float v = 0.f;
            if (i < ce) v = (i < 2) ? base0[64 * i + lane] : base[64 * i + lane];
            inc[k] = v; }
#pragma unroll
        for (int k = 0; k < 9; ++k) { float x = inc[k];
#pragma unroll
            for (int o = 1; o < 64; o <<= 1) { const float t = __shfl_up(x, o); if (lane >= o) x += t; }
            inc[k] = carry + x; carry += __shfl(x, 63); }
        if (lane == 0) tot[wid] = carry;
        __syncthreads();
        float pre = 0.f;
#pragma unroll
        for (int w = 0; w < 8; ++w) { const float t = tot[w]; if (w < wid) pre += t; }
#pragma unroll
        for (int k = 0; k < 9; ++k) { const int i = cs + k; if (i < ce) { const int pidx = 64 * i + lane; outp[pidx] = (pidx < 112) ? INFINITY : pre + inc[k]; } }
        __syncthreads();
    }
}
template <bool DRY> __device__ __forceinline__ void ret_scan_phase(const KP kp_, int G, int tid) {
    const Params p = ldp(kp_);
    bf16_t* KVR = (bf16_t*)(p.ws + WS_KVR);
#pragma unroll 1
    for (int it = blockIdx.x * 512 + tid; it < 131072; it += G * 512) {
        const int bh = it >> 13, off = (it & 8191) * 4, hd = bh & 3;
        const float Gm = exp2f(128.0f * lg2gamma(hd));
        u32x2* base = (u32x2*)(KVR + (size_t)bh * 33 * 32768 + off);
        u32x2 v[33];
#pragma unroll
        for (int c = 0; c < 32; ++c) v[c] = base[(size_t)c * 8192];
        v[32] = (u32x2){0u, 0u};
        f32x4 R = (f32x4){0.f, 0.f, 0.f, 0.f};
#pragma unroll
        for (int c = 0; c < 33; ++c) { const u32x2 rw = pack4(R); if (!DRY || rw.x == 0x12345679u) base[(size_t)c * 8192] = rw;
            R[0] = R[0] * Gm + bf_lo(v[c].x); R[1] = R[1] * Gm + bf_hi(v[c].x); R[2] = R[2] * Gm + bf_lo(v[c].y); R[3] = R[3] * Gm + bf_hi(v[c].y); }
    }
}
template <bool DRY> __device__ __forceinline__ void ret_out_phase(const KP kp_, LAS unsigned char* lds, int vcu, int G, int tid, int wid, int lane) {
    const Params p = ldp(kp_);
    const bf16_t* RQ = (const bf16_t*)(p.ws + WS_RQ); const bf16_t* RK = (const bf16_t*)(p.ws + WS_RK); const bf16_t* VT = (const bf16_t*)(p.ws + WS_VT);
    const bf16_t* KVR = (const bf16_t*)(p.ws + WS_KVR); bf16_t* YB = (bf16_t*)(p.ws + WS_SRG);
    const int l15 = lane & 15, g = lane >> 4;
    constexpr int PITCH = 272, VOFF = 256 * PITCH;
#pragma unroll 1
    for (int u = vcu; u < 512; u += G) {
        const int bh = u >> 5, c = (u & 31) + 1, b = bh >> 2, hd = bh & 3; const float lg = lg2gamma(hd);
        const int nl = 16 * wid + l15;
        const size_t rowq = (size_t)b * PP + 128 * c + nl;
        { const u32x4* rsrc = (const u32x4*)(KVR + ((size_t)(bh * 33 + c)) * 32768);
          u32x4 rr[8], vv[8];
#pragma unroll
          for (int i = 0; i < 8; ++i) { const int q = tid + 512 * i; rr[i] = rsrc[q];
              vv[i] = *(const u32x4*)(VT + ((size_t)(bh * 256 + (q >> 4))) * PP + 128 * c + (q & 15) * 8); }
#pragma unroll
          for (int i = 0; i < 8; ++i) { const int q = tid + 512 * i; const int off = (q >> 4) * PITCH + (q & 15) * 16;
              *(LAS u32x4*)(lds + off) = rr[i]; *(LAS u32x4*)(lds + VOFF + off) = vv[i]; } }
        bf16x8 qf[4];
#pragma unroll
        for (int s = 0; s < 4; ++s) qf[s] = *(const bf16x8*)(RQ + rowq * 512 + hd * 128 + 32 * s + 8 * g);
        __syncthreads();
        f32x4 acc[16];
#pragma unroll
        for (int ti = 0; ti < 16; ++ti) acc[ti] = (f32x4){0.f, 0.f, 0.f, 0.f};
        const LAS unsigned char* rbase = lds + l15 * PITCH + 16 * g;
#pragma unroll
        for (int s = 0; s < 4; ++s)
#pragma unroll
            for (int ti = 0; ti < 16; ++ti) { const bf16x8 a = *(const LAS bf16x8*)(rbase + 16 * ti * PITCH + 64 * s);
                acc[ti] = __builtin_amdgcn_mfma_f32_16x16x32_bf16(a, qf[s], acc[ti], 0, 0, 0); }
        const float xi = exp2f(lg * (float)(nl + 1));
#pragma unroll
        for (int ti = 0; ti < 16; ++ti) acc[ti] = acc[ti] * xi;
        const int nmb = (wid >> 1) + 1;
        const bf16_t* kp = RK + ((size_t)b * PP + 128 * c + l15) * 512 + hd * 128 + 8 * g;
        bf16x8 k0[4], k1[4], kn0[4], kn1[4];
#pragma unroll
        for (int s = 0; s < 4; ++s) { k0[s] = *(const bf16x8*)(kp + 32 * s); k1[s] = *(const bf16x8*)(kp + 16 * 512 + 32 * s); }
#pragma unroll 1
        for (int mb = 0; mb < nmb; ++mb) {
            f32x4 t0 = (f32x4){0.f, 0.f, 0.f, 0.f}, t1 = t0;
            { const bf16_t* kq = kp + (size_t)(mb + 1 < nmb ? mb + 1 : mb) * 32 * 512;
#pragma unroll
              for (int s = 0; s < 4; ++s) { kn0[s] = *(const bf16x8*)(kq + 32 * s); kn1[s] = *(const bf16x8*)(kq + 16 * 512 + 32 * s); } }
#pragma unroll
            for (int s = 0; s < 4; ++s) { t0 = __builtin_amdgcn_mfma_f32_16x16x32_bf16(k0[s], qf[s], t0, 0, 0, 0); t1 = __builtin_amdgcn_mfma_f32_16x16x32_bf16(k1[s], qf[s], t1, 0, 0, 0); }
#pragma unroll
            for (int s = 0; s < 4; ++s) { k0[s] = kn0[s]; k1[s] = kn1[s]; }
#pragma unroll
            for (int r = 0; r < 4; ++r) { const int d0 = nl - (32 * mb + 4 * g + r), d1 = d0 - 16;
                t0[r] = (d0 >= 0) ? t0[r] * exp2f(lg * (float)d0) : 0.f; t1[r] = (d1 >= 0) ? t1[r] * exp2f(lg * (float)d1) : 0.f; }
            const u32x2 s0 = pack4(t0), s1 = pack4(t1);
            const bf16x8 sb = __builtin_bit_cast(bf16x8, ((u32x4){s0.x, s0.y, s1.x, s1.y}));
            const LAS unsigned char* vbase = lds + VOFF + l15 * PITCH + 64 * mb + 8 * g;
#pragma unroll
            for (int ti = 0; ti < 16; ++ti) { const u32x2 lo = *(const LAS u32x2*)(vbase + 16 * ti * PITCH), hi2 = *(const LAS u32x2*)(vbase + 16 * ti * PITCH + 32);
                const bf16x8 a = __builtin_bit_cast(bf16x8, ((u32x4){lo.x, lo.y, hi2.x, hi2.y}));
                acc[ti] = __builtin_amdgcn_mfma_f32_16x16x32_bf16(a, sb, acc[ti], 0, 0, 0); }
        }
        float s = 0.f;
#pragma unroll
        for (int ti = 0; ti < 16; ++ti) s += (acc[ti][0] + acc[ti][1]) + (acc[ti][2] + acc[ti][3]);
        s += __shfl_xor(s, 16); s += __shfl_xor(s, 32);
        const float mean = s * (1.0f / 256.0f); float q = 0.f;
#pragma unroll
        for (int ti = 0; ti < 16; ++ti) { const f32x4 d = acc[ti] - mean; q += (d[0] * d[0] + d[1] * d[1]) + (d[2] * d[2] + d[3] * d[3]); }
        q += __shfl_xor(q, 16); q += __shfl_xor(q, 32);
        const float rstd = rsqrtf(q * (1.0f / 256.0f) + 1e-5f);
#pragma unroll
        for (int ti = 0; ti < 16; ++ti) { const int e0 = 16 * ti + 4 * g;
            const f32x4 gn = *(const f32x4*)(p.rgn + hd * 256 + e0);
            bf16_t* yp = YB + rowq * DM + hd * 256 + e0; const u32x2 sg = *(const u32x2*)yp;
            f32x4 o = (acc[ti] - mean) * rstd * gn; o[0] *= bf_lo(sg.x); o[1] *= bf_hi(sg.x); o[2] *= bf_lo(sg.y); o[3] *= bf_hi(sg.y);
            const u32x2 ow = pack4(o); if (!DRY || ow.x == 0x12345679u) *(u32x2*)yp = ow; }
        __syncthreads();
    }
}

#define XB_TMO      128
#define XB_XCNT(j)  (256  + 64 * (j))
#define XB_XSUB(j)  (1280 + 64 * (j))
#define XB_XGEN(j)  (2304 + 64 * (j))
#define XB_TOP      3328
#define XB_TOPGEN   3392
#define XCD_BAR_WORDS 3456
#define XB_SPIN_CAP (1u << 20)
constexpr size_t WS_BAR = 65536;
constexpr int LDS_MISC = 140000;
__device__ __forceinline__ unsigned xb_ld(unsigned* p)              { return __hip_atomic_load(p, __ATOMIC_RELAXED, __HIP_MEMORY_SCOPE_AGENT); }
__device__ __forceinline__ unsigned xb_add(unsigned* p, unsigned v) { return __hip_atomic_fetch_add(p, v, __ATOMIC_RELAXED, __HIP_MEMORY_SCOPE_AGENT); }
__device__ __forceinline__ unsigned xb_xcc_id() { return (unsigned)__builtin_amdgcn_s_getreg((3 << 11) | 20) & 0xFu; }
#define XB_SPIN(cond, bar) do { unsigned _sp = 0; while (cond) { __builtin_amdgcn_s_sleep(1); \
    if ((++_sp & 255u) == 0u) { if (xb_ld(&(bar)[XB_TMO])) break; if (_sp > XB_SPIN_CAP) { atomicAdd(&(bar)[XB_TMO], 1u); break; } } } } while (0)
__device__ __forceinline__ void xcd_barrier_complete(unsigned* bar, unsigned x, unsigned& nloc, unsigned& nx) {
    const unsigned G = gridDim.x * gridDim.y * gridDim.z;
    unsigned sum, cnt, mine, sp = 0u;
    for (;;) {
        sum = 0u; cnt = 0u; mine = 0u;
#pragma unroll
        for (unsigned j = 0; j < 16; ++j) { const unsigned c = xb_ld(&bar[XB_XCNT(j)]); sum += c; cnt += (c > 0u) ? 1u : 0u; mine = (j == x) ? c : mine; }
        if (sum == G) break;
        __builtin_amdgcn_s_sleep(1);
        if ((++sp & 255u) == 0u) { if (xb_ld(&bar[XB_TMO])) break; if (sp > XB_SPIN_CAP) { atomicAdd(&bar[XB_TMO], 1u); break; } }
    }
    nloc = mine > 0u ? mine : 1u; nx = cnt > 0u ? cnt : 1u;
}
__device__ __forceinline__ void xcd_barrier(unsigned* bar, volatile LAS unsigned* st) {
    asm volatile("s_waitcnt vmcnt(0)" ::: "memory");
    __syncthreads();
    if (threadIdx.x == 0) {
        const unsigned x = xb_xcc_id();
        __builtin_amdgcn_s_waitcnt(0);
        unsigned nloc = st[0], nx = st[1];
        if (nloc == 0u) { xcd_barrier_complete(bar, x, nloc, nx); st[0] = nloc; st[1] = nx; }
        const unsigned old = xb_add(&bar[XB_XSUB(x)], 1u);
        const unsigned gen = old / nloc;
        if (old + 1u == (gen + 1u) * nloc) {
            __builtin_amdgcn_fence(__ATOMIC_RELEASE, "agent");
            asm volatile("s_waitcnt vmcnt(0)" ::: "memory");
            const unsigned og = xb_add(&bar[XB_TOP], 1u);
            const unsigned tg = og / nx;
            if (og + 1u == (tg + 1u) * nx) xb_add(&bar[XB_TOPGEN], 1u);
            else XB_SPIN(xb_ld(&bar[XB_TOPGEN]) == tg, bar);
            __builtin_amdgcn_fence(__ATOMIC_ACQUIRE, "agent");
            xb_add(&bar[XB_XGEN(x)], 1u);
            asm volatile("s_waitcnt vmcnt(0)" ::: "memory");
        } else {
            XB_SPIN(xb_ld(&bar[XB_XGEN(x)]) == gen, bar);
            __builtin_amdgcn_fence(__ATOMIC_ACQUIRE, "agent");
            asm volatile("s_waitcnt vmcnt(0)" ::: "memory");
        }
    }
    __syncthreads();
}

extern __shared__ __attribute__((aligned(16))) unsigned char lds_raw[];
template <bool DRY> __device__ __forceinline__ void run_phase(const int ph) {
        const KP kp = kparams();
        int tid = threadIdx.x; asm volatile("" : "+v"(tid));
        int G = gridDim.x, bx = blockIdx.x; asm volatile("" : "+s"(G), "+s"(bx));
        LAS unsigned char* lds = (LAS unsigned char*)lds_raw;
        const int lane = tid & 63, wid = __builtin_amdgcn_readfirstlane(tid >> 6);
        const int vcu = (G % 8 == 0) ? (bx % 8) * (G / 8) + bx / 8 : bx;
        int gp = -1;
        switch (ph) {
            case 1: gp = pg8::GP_G1; break;
            case 2: gp = pg8::GP_G2; break;
            case 3: gp = pg8::GP_G3R; break;
            case 7: gp = pg8::GP_G3F; break;
            case 9: gp = pg8::GP_MIX; break;
            case 10: gp = pg8::GP_OUT; break;
            case 11: gp = pg8::GP_F2A; break;
            case 12: gp = pg8::GP_F2B; break;
            default: break;
        }
        if (gp >= 0) {
#ifndef NO_GEMM
            pg8::Epi E;
            pg8::Sched S; S.init(gp, G, bx);
            pg8::gemm_phase(lds, S, E);
            if (gp == pg8::GP_G2 && !DRY) thin_g2(kp, lds, bx, wid, lane);
            if (G == 256 && !DRY) {
                if (gp == pg8::GP_G1 && bx >= 172) { const Params p = ldp(kp); convert_range(p, (LAS float*)(lds + wid * 16384), 2, 10, (bx - 172) * 8 + wid, 84 * 8, lane); }
                if (gp == pg8::GP_G3R && bx >= 79) { const Params p = ldp(kp); convert_range(p, (LAS float*)(lds + wid * 16384), 11, 18, (bx - 79) * 8 + wid, 177 * 8, lane); }
            } else if (!DRY) {
                const Params p = ldp(kp);
                if (gp == pg8::GP_G1) convert_range(p, (LAS float*)(lds + wid * 16384), 2, 10, vcu * 8 + wid, G * 8, lane);
                if (gp == pg8::GP_G3R) convert_range(p, (LAS float*)(lds + wid * 16384), 11, 18, vcu * 8 + wid, G * 8, lane);
            }
#endif
        } else if (ph == 0) {
#ifndef NO_P0
            p0_prologue(kp, lds, vcu, G, tid, wid, lane);
#endif
        } else if (ph == 4) {
#ifndef NO_R1
            if (!DRY) cumsum_phase(kp, lds, vcu, G, wid, lane);
            ret_kv_phase(kp, vcu, G, wid, lane);
#endif
        } else if (ph == 5) {
#ifndef NO_R2
            ret_scan_phase<DRY>(kp, G, tid);
#endif
        } else if (ph == 6) {
#ifndef NO_R3
            ret_out_phase<DRY>(kp, lds, vcu, G, tid, wid, lane);
#endif
        } else if (ph == 8) {
#ifndef NO_ATTN
            unsigned char* ws = kp->ws;
            const attn_body::bf16* Qp = (const attn_body::bf16*)(ws + WS_Q); const attn_body::bf16* Kp = (const attn_body::bf16*)(ws + WS_K); const attn_body::bf16* Vp = (const attn_body::bf16*)(ws + WS_V);
            const float* C2 = (const float*)(ws + WS_C2);
            const int nun = (G == 256) ? 4 : (1024 - vcu + G - 1) / G;
#pragma unroll 1
            for (int i = 0; i < nun; ++i) {
                int bh, qb;
                if (G == 256) { const int s = vcu & 3; bh = vcu >> 2; qb = (i == 0) ? s : (i == 1) ? 7 - s : (i == 2) ? 8 + s : 15 - s; }
                else { const int idx = vcu + i * G; bh = idx >> 4; qb = idx & 15; }
                attn_body::attn_unit<32, DRY>(bh >> 4, bh & 15, qb, Qp, Kp, Vp, (const attn_body::bf16*)(ws + WS_KLEAD), (const attn_body::bf16*)(ws + WS_VLEAD), (attn_body::bf16*)(ws + WS_Q), C2, (char*)lds_raw);
            }
#endif
        }
}
#ifndef MULTI
#ifndef PROBE_PH
#define PROBE_PH -1
#endif
__global__ void __launch_bounds__(512, 2) fwd_megakernel(Params p_unused) {
    cg::grid_group grid = cg::this_grid();
    { volatile LAS unsigned* st = (volatile LAS unsigned*)((LAS unsigned char*)lds_raw + LDS_MISC);
      if (threadIdx.x == 0) { st[0] = 0u; st[1] = 0u; (void)xb_add((unsigned*)(kparams()->ws + WS_BAR) + XB_XCNT(xb_xcc_id()), 1u); }
      __syncthreads(); }
    if (gridDim.x > 65536u) grid.sync();
#pragma unroll 1
    for (int ph = 0; ph <= LAST_PHASE; ++ph) {
        if (PROBE_PH >= 0 && ph == PROBE_PH) { run_phase<true>(ph); xcd_barrier((unsigned*)(kparams()->ws + WS_BAR), (volatile LAS unsigned*)((LAS unsigned char*)lds_raw + LDS_MISC)); }
        run_phase<false>(ph);
        if (ph < 12) xcd_barrier((unsigned*)(kparams()->ws + WS_BAR), (volatile LAS unsigned*)((LAS unsigned char*)lds_raw + LDS_MISC));
    }
}
#else
template <int PH> __global__ void __launch_bounds__(512, 2) phase_kernel(Params p_unused) { run_phase<false>(PH); }
__global__ void __launch_bounds__(512, 2) gemm_kernel(Params p_unused, int ph) { run_phase<false>(ph == 1 ? 1 : ph == 2 ? 2 : ph == 3 ? 3 : ph == 7 ? 7 : ph == 9 ? 9 : ph == 10 ? 10 : ph == 11 ? 11 : 12); }
#endif

extern "C" void kernel_launch(void* const* d_in, const int* in_sizes, int n_in, void* d_out, int out_size, void* d_ws, size_t ws_size, hipStream_t stream) {
    static int grid = 0;
    if (grid == 0) {
        int dev = 0, cus = 0, per_cu = 0;
        if (hipGetDevice(&dev) != hipSuccess || hipDeviceGetAttribute(&cus, hipDeviceAttributeMultiprocessorCount, dev) != hipSuccess) { fprintf(stderr, "kernel_launch: device query failed\n"); grid = -1; return; }
#ifndef MULTI
        if (hipFuncSetAttribute((const void*)fwd_megakernel, hipFuncAttributeMaxDynamicSharedMemorySize, LDS_BYTES) != hipSuccess) { fprintf(stderr, "kernel_launch: hipFuncSetAttribute failed\n"); grid = -1; return; }
        if (hipOccupancyMaxActiveBlocksPerMultiprocessor(&per_cu, (const void*)fwd_megakernel, 512, LDS_BYTES) != hipSuccess || per_cu < 1) { fprintf(stderr, "kernel_launch: occupancy query says %d\n", per_cu); per_cu = 1; }
#else
        hipFuncSetAttribute((const void*)phase_kernel<0>, hipFuncAttributeMaxDynamicSharedMemorySize, LDS_BYTES);
        hipFuncSetAttribute((const void*)phase_kernel<4>, hipFuncAttributeMaxDynamicSharedMemorySize, LDS_BYTES);
        hipFuncSetAttribute((const void*)phase_kernel<5>, hipFuncAttributeMaxDynamicSharedMemorySize, LDS_BYTES);
        hipFuncSetAttribute((const void*)phase_kernel<6>, hipFuncAttributeMaxDynamicSharedMemorySize, LDS_BYTES);
        hipFuncSetAttribute((const void*)phase_kernel<8>, hipFuncAttributeMaxDynamicSharedMemorySize, LDS_BYTES);
        hipFuncSetAttribute((const void*)gemm_kernel, hipFuncAttributeMaxDynamicSharedMemorySize, LDS_BYTES);
#endif
        (void)hipGetLastError();
        grid = cus;
    }
    if (grid < 0) return;
    Params p{};
    p.x = (const float*)d_in[0]; p.meta = (const float*)d_in[1]; p.n1 = (const float*)d_in[2]; p.w1i = (const float*)d_in[3]; p.w1o = (const float*)d_in[4];
    p.nm = (const float*)d_in[5]; p.win = (const float*)d_in[6]; p.bfg = (const float*)d_in[7]; p.bgate = (const float*)d_in[8]; p.qn = (const float*)d_in[9];
    p.kn = (const float*)d_in[10]; p.wof = (const float*)d_in[11]; p.rgn = (const float*)d_in[12]; p.wor = (const float*)d_in[13]; p.wout = (const float*)d_in[14];
    p.n2 = (const float*)d_in[15]; p.w2i = (const float*)d_in[16]; p.w2o = (const float*)d_in[17];
    p.out = (float*)d_out; p.ws = (unsigned char*)d_ws;
#ifndef MULTI
    if (hipMemsetAsync((char*)d_ws + WS_BAR, 0, XCD_BAR_WORDS * 4, stream) != hipSuccess) { fprintf(stderr, "kernel_launch: memset failed\n"); return; }
    void* args[] = {&p};
    hipError_t e = hipLaunchCooperativeKernel((const void*)fwd_megakernel, dim3(grid), dim3(512), args, LDS_BYTES, stream);
    if (e != hipSuccess) fprintf(stderr, "cooperative launch failed: %s (grid %d)\n", hipGetErrorString(e), grid);
#else
    for (int ph = 0; ph <= LAST_PHASE; ++ph) {
        switch (ph) {
            case 0: hipLaunchKernelGGL(phase_kernel<0>, dim3(grid), dim3(512), LDS_BYTES, stream, p); break;
            case 4: hipLaunchKernelGGL(phase_kernel<4>, dim3(grid), dim3(512), LDS_BYTES, stream, p); break;
            case 5: hipLaunchKernelGGL(phase_kernel<5>, dim3(grid), dim3(512), LDS_BYTES, stream, p); break;
            case 6: hipLaunchKernelGGL(phase_kernel<6>, dim3(grid), dim3(512), LDS_BYTES, stream, p); break;
            case 8: hipLaunchKernelGGL(phase_kernel<8>, dim3(grid), dim3(512), LDS_BYTES, stream, p); break;
            default: hipLaunchKernelGGL(gemm_kernel, dim3(grid), dim3(512), LDS_BYTES, stream, p, ph); break;
        }
    }
#endif
}
```

```cpp
#include <hip/hip_runtime.h>
#include <hip/hip_cooperative_groups.h>
#include <hip/hip_bf16.h>
#include <cstdio>
#include <cstdint>
#include <cmath>
namespace cg = cooperative_groups;

#ifndef LAST_PHASE
#define LAST_PHASE 12
#endif

#define LAS __attribute__((address_space(3)))
typedef unsigned short bf16_t;
typedef short bf16x8 __attribute__((ext_vector_type(8)));
typedef float f32x4 __attribute__((ext_vector_type(4)));
typedef float f32x16 __attribute__((ext_vector_type(16)));
typedef unsigned u32x4 __attribute__((ext_vector_type(4)));
typedef unsigned u32x2 __attribute__((ext_vector_type(2)));
typedef short s16x4 __attribute__((ext_vector_type(4)));

constexpr int DM = 1024, NB = 4, SEQ = 4096, PP = 4224, MP = NB * PP  , DFF = 2816, NINC = 8208;
constexpr int NMP = MP / 256  , NMR = 64;
constexpr float LOG2E = 1.4426950408889634f;
constexpr float QC2 = 0.125f * LOG2E;

constexpr size_t MiB = 1u << 20;
constexpr size_t WS_SSQ1 = 1 * MiB, WS_SSQ2 = 2 * MiB + 256 * 1024, WS_SSQ0 = 3 * MiB + 512 * 1024, WS_LOGF = 4 * MiB + 768 * 1024;
constexpr size_t WS_COS = 6 * MiB, WS_SIN = 7 * MiB + 256 * 1024;
constexpr size_t WS_W1A = 9 * MiB, WS_W1B = 20 * MiB, WS_WIN = 25 * MiB + 512 * 1024, WS_WOF = 42 * MiB, WS_WOR = 44 * MiB, WS_WOUT = 46 * MiB;
constexpr size_t WS_W2A = 48 * MiB, WS_W2B = 59 * MiB;
constexpr size_t WS_XB = 65 * MiB;
constexpr size_t WS_BIG = 98 * MiB;
constexpr size_t WS_HID = WS_BIG;
constexpr size_t WS_RQ = WS_BIG, WS_RK = WS_BIG + 16 * MiB + 512 * 1024, WS_KT = WS_BIG + 33 * MiB, WS_VT = WS_BIG + 49 * MiB + 512 * 1024;
constexpr size_t WS_SRG = WS_BIG + 82 * MiB + 512 * 1024, WS_KVR = WS_BIG + 115 * MiB + 512 * 1024;
constexpr size_t WS_Q = WS_BIG, WS_K = WS_BIG + 33 * MiB, WS_V = WS_KVR;
constexpr size_t WS_T1 = WS_K, WS_GB = WS_V;
constexpr size_t WS_KLEAD = 128 * 1024, WS_VLEAD = 384 * 1024;
constexpr size_t WS_C2 = 9 * MiB;
static_assert(WS_KVR + 33 * MiB + 512 * 1024 <= 256 * MiB, "ws map");
constexpr int WIN_RET = 0, WIN_FOX = 3328, WIN_GA = 6400, WIN_GB = 7424, WIN_ROWS = 8448;

struct Params {
    const float* x; const float* meta; const float* n1; const float* w1i; const float* w1o; const float* nm; const float* win;
    const float* bfg; const float* bgate; const float* qn; const float* kn; const float* wof; const float* rgn; const float* wor;
    const float* wout; const float* n2; const float* w2i; const float* w2o;
    float* out; unsigned char* ws;
};

typedef const __attribute__((address_space(4))) Params* KP;
__device__ __forceinline__ Params ldp(KP kp) { Params p; p.x = kp->x; p.meta = kp->meta; p.n1 = kp->n1; p.w1i = kp->w1i; p.w1o = kp->w1o; p.nm = kp->nm; p.win = kp->win; p.bfg = kp->bfg; p.bgate = kp->bgate; p.qn = kp->qn; p.kn = kp->kn; p.wof = kp->wof; p.rgn = kp->rgn; p.wor = kp->wor; p.wout = kp->wout; p.n2 = kp->n2; p.w2i = kp->w2i; p.w2o = kp->w2o; p.out = kp->out; p.ws = kp->ws; return p; }
__device__ __forceinline__ KP kparams() { KP kp = (KP)__builtin_amdgcn_kernarg_segment_ptr(); asm volatile("" : "+s"(kp)); return kp; }
typedef float f32x2c __attribute__((ext_vector_type(2))); typedef __bf16 bf16x2c __attribute__((ext_vector_type(2)));
__device__ __forceinline__ unsigned cvt_pk_bf16(float lo, float hi) { const f32x2c v = {lo, hi}; const bf16x2c b = __builtin_convertvector(v, bf16x2c); return __builtin_bit_cast(unsigned, b); }
__device__ __forceinline__ float bf_lo(unsigned w) { return __uint_as_float(w << 16); }
__device__ __forceinline__ float bf_hi(unsigned w) { return __uint_as_float(w & 0xffff0000u); }
__device__ __forceinline__ float silu_f(float v) { return v * __builtin_amdgcn_rcpf(1.0f + __builtin_amdgcn_exp2f(-v * LOG2E)); }
__device__ __forceinline__ float sigm_f(float v) { return __builtin_amdgcn_rcpf(1.0f + __builtin_amdgcn_exp2f(-v * LOG2E)); }
__device__ __forceinline__ u32x4 pack8(f32x4 a, f32x4 b) { u32x4 w; w.x = cvt_pk_bf16(a[0], a[1]); w.y = cvt_pk_bf16(a[2], a[3]); w.z = cvt_pk_bf16(b[0], b[1]); w.w = cvt_pk_bf16(b[2], b[3]); return w; }
__device__ __forceinline__ u32x2 pack4(f32x4 a) { u32x2 w; w.x = cvt_pk_bf16(a[0], a[1]); w.y = cvt_pk_bf16(a[2], a[3]); return w; }
__device__ __forceinline__ float row_rstd(const float* ssq, int row, int fq) {
    const f32x4 v = *(const f32x4*)(ssq + (size_t)row * 16 + 4 * fq);
    float s = (v[0] + v[1]) + (v[2] + v[3]);
    s += __shfl_xor(s, 16); s += __shfl_xor(s, 32);
    return rsqrtf(s * (1.0f / 1024.0f) + 1e-6f);
}
__device__ __forceinline__ float wave_sum(float v) {
#pragma unroll
    for (int o = 1; o < 64; o <<= 1) v += __shfl_xor(v, o);
    return v;
}
#define LDS_WAIT() asm volatile("s_waitcnt lgkmcnt(0)" ::: "memory")

namespace pg8 {
constexpr int BM = 256, BK = 64, HALF = 128, HTB = HALF * BK * 2, NXCD = 8, WGM = 4;
__device__ __forceinline__ int lds_byte(int r, int c) { const int st = (r >> 4) * 2 + (c >> 5), rr = r & 15, cc = c & 31, ob = rr * 64 + cc * 2; return st * 1024 + (ob ^ (((ob >> 9) & 1) << 5)); }
__device__ __forceinline__ void stage_rc(int b, int& R, int& C) { const int st = b / 1024, sb = b % 1024, swz = sb ^ (((sb >> 9) & 1) << 5); R = (st >> 1) * 16 + swz / 64; C = (st & 1) * 32 + (swz % 64) / 2; }
__device__ __forceinline__ int perm32(int rho) { const int n = rho >> 4, i = rho & 15; return 8 * (i >> 2) + 4 * n + (i & 3); }

struct Unit { const char* a; const char* b; unsigned meta; };

enum Kind { K_SWIGLU = 0, K_RES1, K_RES2, K_FINAL, K_RQ, K_RK, K_RV, K_RG, K_FF, K_FQ, K_FK, K_FV, K_GA, K_MIXA, K_GB, K_MIXB };
enum GPhase { GP_G1 = 0, GP_G2, GP_G3R, GP_G3F, GP_MIX, GP_OUT, GP_F2A, GP_F2B };

struct Sched {
    int gp, G, c;
    __device__ __forceinline__ void init(int gp_, int G_, int c_) { gp = gp_; G = G_; c = c_; }
    __device__ __forceinline__ int kdim() const { return (gp == GP_G2 || gp == GP_F2B) ? DFF : 1024; }
    __device__ __forceinline__ bool next(int i, Unit& u) const {
        int nN, nM = NMR, real = 1, chain = 1;
        switch (gp) {
            case GP_G1: nN = 22; nM = NMP; real = 0; break;
            case GP_G2: nN = 4; break;
            case GP_G3R: nN = 13; break;
            case GP_G3F: nN = 12; break;
            case GP_MIX: nN = 4; chain = 4; break;
            case GP_OUT: nN = 4; break;
            case GP_F2A: nN = 22; break;
            default: nN = 4; break;
        }
        const int K = kdim(), nwg = nM * nN;
        const int ti = (chain == 4) ? (i >> 2) : i, sub = (chain == 4) ? (i & 3) : 0;
        const long L = (long)ti * G + c;
        if (gp == GP_G3R && L >= nwg) {
            const int j = (int)(L - nwg); if (j >= 15) return false;
            int kind, aux, brow;
            if (j < 2) { kind = K_RK; aux = j; brow = WIN_RET + (2 + j) * 256; } else if (j < 6) { kind = K_RV; aux = j - 2; brow = WIN_RET + (2 + j) * 256; }
            else if (j == 6) { kind = K_FF; aux = 0; brow = WIN_RET + 12 * 256; } else if (j < 11) { kind = K_FK; aux = (j - 7) | 4; brow = WIN_FOX + (j - 3) * 256; }
            else { kind = K_FV; aux = (j - 11) | 4; brow = WIN_FOX + (j - 3) * 256; }
            u.meta = ((unsigned)kind << 21) | ((unsigned)aux << 25);
            const char* ws = (const char*)kparams()->ws;
            u.a = ws + WS_XB; u.b = ws + WS_WIN + (size_t)brow * K * 2;
            return true;
        }
        if (L >= nwg) return false;
        int wgid = (int)L; { const int q = nwg / NXCD, r = nwg % NXCD, xcd = wgid % NXCD, off = wgid / NXCD; wgid = (xcd < r ? xcd * (q + 1) : r * (q + 1) + (xcd - r) * q) + off; }
        const int nig = WGM * nN, gid = wgid / nig, fm = gid * WGM, gsz = (nM - fm) < WGM ? (nM - fm) : WGM;
        const int pm = fm + ((wgid % nig) % gsz), pn = (wgid % nig) / gsz;
        const int row0 = real ? ((pm >> 4) * PP + 128 + (pm & 15) * 256) : pm * 256;
        int aux = 0;
        size_t aoff = WS_XB, boff = 0; int brow = pn * 256, kind = 0;
        switch (gp) {
            case GP_G1: boff = WS_W1A; kind = K_SWIGLU; break;
            case GP_G2: aoff = WS_HID; boff = WS_W1B; kind = K_RES1; break;
            case GP_G3R: boff = WS_WIN; brow = WIN_RET + pn * 256;
                if (pn < 2) { kind = K_RQ; aux = pn; } else if (pn < 4) { kind = K_RK; aux = pn - 2; } else if (pn < 8) { kind = K_RV; aux = pn - 4; } else if (pn < 12) { kind = K_RG; aux = pn - 8; } else kind = K_FF;
                break;
            case GP_G3F: boff = WS_WIN; brow = WIN_FOX + pn * 256;
                if (pn < 4) { kind = K_FQ; aux = pn; } else if (pn < 8) { kind = K_FK; aux = pn - 4; } else { kind = K_FV; aux = pn - 8; }
                break;
            case GP_MIX:
                if (sub == 0) { boff = WS_WIN; brow = WIN_GA + pn * 256; kind = K_GA; }
                else if (sub == 1) { aoff = WS_Q; boff = WS_WOF; kind = K_MIXA; }
                else if (sub == 2) { boff = WS_WIN; brow = WIN_GB + pn * 256; kind = K_GB; }
                else { aoff = WS_SRG; boff = WS_WOR; kind = K_MIXB; }
                break;
            case GP_OUT: aoff = WS_T1; boff = WS_WOUT; kind = K_RES2; break;
            case GP_F2A: boff = WS_W2A; kind = K_SWIGLU; aux = 1; break;
            default: aoff = WS_HID; boff = WS_W2B; kind = K_FINAL; break;
        }
        u.meta = (unsigned)row0 | ((unsigned)pn << 16) | ((unsigned)kind << 21) | ((unsigned)aux << 25);
        const char* ws = (const char*)kparams()->ws;
        u.a = ws + aoff + (size_t)row0 * K * 2;
        u.b = ws + boff + (size_t)brow * K * 2;
        return true;
    }
};

struct Epi {
    __device__ __forceinline__ void operator()(const f32x4 (&acc)[2][2][4][2], const Unit& u, int wr, int wc, int fr, int fq) const {
        asm volatile("" : "+v"(fr), "+v"(fq), "+s"(wr), "+s"(wc));
        const KP kp = kparams();
        unsigned char* ws = kp->ws;
        const int kind = (u.meta >> 21) & 15, pn = (u.meta >> 16) & 31, u_aux = (u.meta >> 25) & 7, u_row0 = u.meta & 0xffff, u_col0 = pn << 8;
        float rsv[2][4];
        if (!(kind == K_RES1 || kind == K_RES2 || kind == K_FINAL || kind == K_MIXA || kind == K_MIXB)) {
            const float* ssqp = (const float*)(ws + (kind == K_SWIGLU ? (u_aux ? WS_SSQ2 : WS_SSQ0) : WS_SSQ1));
            f32x4 sv[2][4];
#pragma unroll
            for (int ai = 0; ai < 2; ++ai)
#pragma unroll
                for (int m = 0; m < 4; ++m) sv[ai][m] = *(const f32x4*)(ssqp + (size_t)(u_row0 + ai * 128 + wr * 64 + m * 16 + fr) * 16 + 4 * fq);
#pragma unroll
            for (int ai = 0; ai < 2; ++ai)
#pragma unroll
                for (int m = 0; m < 4; ++m) { float sx = (sv[ai][m][0] + sv[ai][m][1]) + (sv[ai][m][2] + sv[ai][m][3]); sx += __shfl_xor(sx, 16); sx += __shfl_xor(sx, 32); rsv[ai][m] = rsqrtf(sx * (1.0f / 1024.0f) + 1e-6f); }
        } else {
#pragma unroll
            for (int ai = 0; ai < 2; ++ai)
#pragma unroll
                for (int m = 0; m < 4; ++m) rsv[ai][m] = 1.0f;
        }
#define FOR_ROWS _Pragma("unroll") for (int ai = 0; ai < 2; ++ai) _Pragma("unroll") for (int m = 0; m < 4; ++m)
#define ROWDEF const int row = u_row0 + ai * 128 + wr * 64 + m * 16 + fr
        if (kind == K_SWIGLU) {
            const float* ssq = (const float*)(ws + (u_aux ? WS_SSQ2 : WS_SSQ0));
            bf16_t* H = (bf16_t*)(ws + WS_HID);
            const int hc = (u_col0 >> 1) + wc * 32 + 8 * fq;
            FOR_ROWS { ROWDEF; const float rs = rsv[ai][m];
                f32x4 o[2];
#pragma unroll
                for (int n = 0; n < 2; ++n) { const f32x4 a = acc[ai][0][m][n] * rs, b = acc[ai][1][m][n] * rs;
#pragma unroll
                    for (int e = 0; e < 4; ++e) o[n][e] = silu_f(a[e]) * b[e]; }
                *(u32x4*)(H + (size_t)row * DFF + hc) = pack8(o[0], o[1]); }
        } else if (kind == K_RES1 || kind == K_RES2 || kind == K_FINAL) {
            float* ssq = (float*)(ws + (kind == K_RES1 ? WS_SSQ1 : WS_SSQ2));
            bf16_t* HB = (bf16_t*)(ws + WS_XB);
            const float sc = (kind == K_RES2) ? 1.0f : 0.5f;
            const int c0 = u_col0 + wc * 32 + 8 * fq;
#pragma unroll
            for (int aim = 0; aim < 4; ++aim) { const int ai = aim >> 1, m0 = 2 * (aim & 1);
                f32x4 bs[4][2][2]; u32x4 hb[4][2];
#pragma unroll
                for (int m = m0; m < m0 + 2; ++m) { ROWDEF; const int b = row / PP, pidx = row - b * PP;
                    if (false) {
                    } else {
#pragma unroll
                        for (int bj = 0; bj < 2; ++bj) { hb[m][bj] = *(const u32x4*)(HB + (size_t)row * DM + c0 + bj * 128); bs[m][bj][0] = (f32x4){0.f, 0.f, 0.f, 0.f}; bs[m][bj][1] = bs[m][bj][0]; }
                    } }
                asm volatile("" ::: "memory");
#pragma unroll
                for (int m = m0; m < m0 + 2; ++m) { ROWDEF; const int b = row / PP, pidx = row - b * PP; float ss = 0.f;
                    float* op = kp->out + ((size_t)(b * SEQ + pidx - 128)) * DM + c0;
#pragma unroll
                    for (int bj = 0; bj < 2; ++bj) {
                        f32x4 b0 = bs[m][bj][0], b1 = bs[m][bj][1];
                        { const u32x4 t = hb[m][bj]; b0 = (f32x4){bf_lo(t.x), bf_hi(t.x), bf_lo(t.y), bf_hi(t.y)}; b1 = (f32x4){bf_lo(t.z), bf_hi(t.z), bf_lo(t.w), bf_hi(t.w)}; }
                        const f32x4 v0 = b0 + acc[ai][bj][m][0] * sc, v1 = b1 + acc[ai][bj][m][1] * sc;
                        if (kind == K_FINAL) { *(f32x4*)(op + bj * 128) = v0; *(f32x4*)(op + bj * 128 + 4) = v1; }
                        else { *(u32x4*)(HB + (size_t)row * DM + c0 + bj * 128) = pack8(v0, v1);
                            ss += (v0[0] * v0[0] + v0[1] * v0[1]) + (v0[2] * v0[2] + v0[3] * v0[3]) + (v1[0] * v1[0] + v1[1] * v1[1]) + (v1[2] * v1[2] + v1[3] * v1[3]); }
                    }
                    if (kind != K_FINAL) { ss += __shfl_xor(ss, 16); ss += __shfl_xor(ss, 32);
                        if (fq == 0) ssq[(size_t)row * 16 + pn * 4 + wc] = ss; } }
            }
        } else if (kind == K_RQ || kind == K_RK) {
            const float* ssq = (const float*)(ws + WS_SSQ1);
            const float* COS = (const float*)(ws + WS_COS); const float* SIN = (const float*)(ws + WS_SIN);
            const int hh = wc >> 1, i0 = 32 * (wc & 1) + 8 * fq, hd = 2 * u_aux + hh;
            bf16_t* RQ = (bf16_t*)(ws + (kind == K_RQ ? WS_RQ : WS_RK)); bf16_t* KT = (bf16_t*)(ws + WS_KT);
#pragma unroll
            for (int aim = 0; aim < 4; ++aim) { const int ai = aim >> 1, m0 = 2 * (aim & 1);
                f32x4 csv[4][2], snv[4][2];
#pragma unroll
                for (int m = m0; m < m0 + 2; ++m) { ROWDEF; const int b = row / PP, pidx = row - b * PP;
#pragma unroll
                    for (int n = 0; n < 2; ++n) { csv[m][n] = *(const f32x4*)(COS + (size_t)pidx * 64 + i0 + 4 * n); snv[m][n] = *(const f32x4*)(SIN + (size_t)pidx * 64 + i0 + 4 * n); } }
#pragma unroll
                for (int m = m0; m < m0 + 2; ++m) { ROWDEF; const float rs = rsv[ai][m]; const int b = row / PP, pidx = row - b * PP;
                    const float ksc = (kind == K_RK) ? (pidx >= 112 ? 0.08838834764831845f : 0.f) : 1.0f;
                    f32x4 y1v[2], y2v[2];
#pragma unroll
                    for (int n = 0; n < 2; ++n) {
                        const f32x4 cs = csv[m][n], sn = snv[m][n];
                        const f32x4 x1 = acc[ai][0][m][n] * rs, x2 = acc[ai][1][m][n] * rs;
                        y1v[n] = (x1 * cs - x2 * sn) * ksc; y2v[n] = (x2 * cs + x1 * sn) * ksc;
                        if (kind == K_RK) {
                            bf16_t* kt = KT + ((size_t)((b * 4 + hd) * 128 + i0 + 4 * n)) * PP + pidx;
#pragma unroll
                            for (int e = 0; e < 4; ++e) { kt[(size_t)e * PP] = (bf16_t)cvt_pk_bf16(y1v[n][e], 0.f); kt[(size_t)(64 + e) * PP] = (bf16_t)cvt_pk_bf16(y2v[n][e], 0.f); }
                        }
                    }
                    { bf16_t* o = RQ + (size_t)row * 512 + hd * 128 + i0;
                      *(u32x4*)o = pack8(y1v[0], y1v[1]); *(u32x4*)(o + 64) = pack8(y2v[0], y2v[1]); } }
            }
        } else if (kind == K_RV) {
            const float* ssq = (const float*)(ws + WS_SSQ1); bf16_t* VT = (bf16_t*)(ws + WS_VT); const int hd = u_aux;
            FOR_ROWS { ROWDEF; float rs = rsv[ai][m]; const int b = row / PP, pidx = row - b * PP; if (pidx < 112) rs = 0.f;
#pragma unroll
                for (int bj = 0; bj < 2; ++bj)
#pragma unroll
                    for (int n = 0; n < 2; ++n) { const f32x4 v = acc[ai][bj][m][n] * rs; const int e0 = 128 * bj + 32 * wc + 8 * fq + 4 * n;
                        bf16_t* vt = VT + ((size_t)((b * 4 + hd) * 256 + e0)) * PP + pidx;
#pragma unroll
                        for (int e = 0; e < 4; ++e) vt[(size_t)e * PP] = (bf16_t)cvt_pk_bf16(v[e], 0.f); } }
        } else if (kind == K_RG || kind == K_FV) {
            const float* ssq = (const float*)(ws + WS_SSQ1); const bool lead = (u_aux & 4) != 0; bf16_t* O = (bf16_t*)(ws + (kind == K_RG ? WS_SRG : (lead ? WS_VLEAD : WS_V)));
            const int c0 = 256 * (u_aux & 3) + wc * 32 + 8 * fq;
            FOR_ROWS { ROWDEF; const float rs = rsv[ai][m];
#pragma unroll
                for (int bj = 0; bj < 2; ++bj) { f32x4 v0 = acc[ai][bj][m][0] * rs, v1 = acc[ai][bj][m][1] * rs;
                    if (kind == K_RG) {
#pragma unroll
                        for (int e = 0; e < 4; ++e) { v0[e] = silu_f(v0[e]); v1[e] = silu_f(v1[e]); } }
                    if (!lead || row < 128) *(u32x4*)(O + (size_t)row * DM + c0 + bj * 128) = pack8(v0, v1); } }
        } else if (kind == K_FF) {
            const float* ssq = (const float*)(ws + WS_SSQ1); float* LF = (float*)(ws + WS_LOGF);
            float fb[2][4];
#pragma unroll
            for (int n = 0; n < 2; ++n)
#pragma unroll
                for (int e = 0; e < 4; ++e) fb[n][e] = kp->bfg[(8 * fq + 4 * n + e) & 15];
            FOR_ROWS { ROWDEF; const float rs = rsv[ai][m]; const int b = row / PP, pidx = row - b * PP;
                if (wc == 0 && fq < 2) {
#pragma unroll
                    for (int n = 0; n < 2; ++n)
#pragma unroll
                        for (int e = 0; e < 4; ++e) { const int hx = 8 * fq + 4 * n + e; const float v = acc[ai][0][m][n][e] * rs + fb[n][e];
                            const float lf = fminf(v, 0.f) * LOG2E - __builtin_amdgcn_logf(1.0f + __builtin_amdgcn_exp2f(-fabsf(v) * LOG2E));
                            LF[((size_t)(b * 16 + hx)) * PP + pidx] = (pidx >= 112) ? lf : 0.f; } } }
        } else if (kind == K_FQ || kind == K_FK) {
            const float* ssq = (const float*)(ws + WS_SSQ1); const bool lead = (u_aux & 4) != 0; bf16_t* O = (bf16_t*)(ws + (kind == K_FQ ? WS_Q : (lead ? WS_KLEAD : WS_K)));
            const float* gn = (kind == K_FQ) ? kp->qn : kp->kn; const float osc = (kind == K_FQ) ? QC2 : 1.0f;
            const int head = 4 * (u_aux & 3) + wc;
            f32x4 gq[2][2];
#pragma unroll
            for (int bj = 0; bj < 2; ++bj) { gq[bj][0] = *(const f32x4*)(gn + 32 * bj + 8 * fq); gq[bj][1] = *(const f32x4*)(gn + 32 * bj + 8 * fq + 4); }
            FOR_ROWS { ROWDEF; const float rs = rsv[ai][m];
                f32x4 v[2][2]; float ss = 0.f;
#pragma unroll
                for (int bj = 0; bj < 2; ++bj)
#pragma unroll
                    for (int n = 0; n < 2; ++n) { v[bj][n] = acc[ai][bj][m][n] * rs; const f32x4 t = v[bj][n]; ss += (t[0] * t[0] + t[1] * t[1]) + (t[2] * t[2] + t[3] * t[3]); }
                ss += __shfl_xor(ss, 16); ss += __shfl_xor(ss, 32);
                const float r2 = rsqrtf(ss * (1.0f / 64.0f) + 1e-6f) * osc;
#pragma unroll
                for (int bj = 0; bj < 2; ++bj) { const f32x4 g0 = gq[bj][0], g1 = gq[bj][1];
                    if (!lead || row < 128) *(u32x4*)(O + (size_t)row * DM + head * 64 + 32 * bj + 8 * fq) = pack8(v[bj][0] * g0 * r2, v[bj][1] * g1 * r2); } }
        } else if (kind == K_GA || kind == K_GB) {
            bf16_t* O = (bf16_t*)(ws + (kind == K_GA ? WS_T1 : WS_GB));
            const int c0 = u_col0 + wc * 32 + 8 * fq;
            f32x4 gq[2][2];
#pragma unroll
            for (int bj = 0; bj < 2; ++bj) { const float* bg = kp->bgate + (kind == K_GB ? 1024 : 0) + c0 + bj * 128; gq[bj][0] = *(const f32x4*)bg; gq[bj][1] = *(const f32x4*)(bg + 4); }
            FOR_ROWS { ROWDEF; const float rs = rsv[ai][m];
#pragma unroll
                for (int bj = 0; bj < 2; ++bj) { const int c = c0 + bj * 128; f32x4 v0 = acc[ai][bj][m][0], v1 = acc[ai][bj][m][1];
#pragma unroll
                    for (int e = 0; e < 4; ++e) { v0[e] = sigm_f(v0[e] * rs + gq[bj][0][e]); v1[e] = sigm_f(v1[e] * rs + gq[bj][1][e]); }
                    *(u32x4*)(O + (size_t)row * DM + c) = pack8(v0, v1); } }
        } else {
            bf16_t* T1 = (bf16_t*)(ws + WS_T1); bf16_t* GB = (bf16_t*)(ws + WS_GB);
            const int c0 = u_col0 + wc * 32 + 8 * fq;
#pragma unroll
            for (int aim = 0; aim < 4; ++aim) { const int ai = aim >> 1, m0 = 2 * (aim & 1);
                u32x4 tt[4][2], gg[4][2];
#pragma unroll
                for (int m = m0; m < m0 + 2; ++m) { ROWDEF;
#pragma unroll
                    for (int bj = 0; bj < 2; ++bj) { tt[m][bj] = *(const u32x4*)(T1 + (size_t)row * DM + c0 + bj * 128); gg[m][bj] = (u32x4){0u, 0u, 0u, 0u}; if (kind == K_MIXB) gg[m][bj] = *(const u32x4*)(GB + (size_t)row * DM + c0 + bj * 128); } }
#pragma unroll
                for (int m = m0; m < m0 + 2; ++m) { ROWDEF;
#pragma unroll
                    for (int bj = 0; bj < 2; ++bj) { f32x4 v0 = acc[ai][bj][m][0], v1 = acc[ai][bj][m][1]; const u32x4 t = tt[m][bj], g = gg[m][bj];
                        if (kind == K_MIXA) {
                            v0[0] *= bf_lo(t.x); v0[1] *= bf_hi(t.x); v0[2] *= bf_lo(t.y); v0[3] *= bf_hi(t.y); v1[0] *= bf_lo(t.z); v1[1] *= bf_hi(t.z); v1[2] *= bf_lo(t.w); v1[3] *= bf_hi(t.w);
                        } else {
                            v0[0] = bf_lo(t.x) + bf_lo(g.x) * v0[0]; v0[1] = bf_hi(t.x) + bf_hi(g.x) * v0[1]; v0[2] = bf_lo(t.y) + bf_lo(g.y) * v0[2]; v0[3] = bf_hi(t.y) + bf_hi(g.y) * v0[3];
                            v1[0] = bf_lo(t.z) + bf_lo(g.z) * v1[0]; v1[1] = bf_hi(t.z) + bf_hi(g.z) * v1[1]; v1[2] = bf_lo(t.w) + bf_lo(g.w) * v1[2]; v1[3] = bf_hi(t.w) + bf_hi(g.w) * v1[3];
                        }
                        *(u32x4*)(T1 + (size_t)row * DM + c0 + bj * 128) = pack8(v0, v1); } }
            }
        }
#undef FOR_ROWS
#undef ROWDEF
    }
};

__device__ __forceinline__ void gemm_phase(LAS unsigned char* lds, const Sched& S, const Epi& E) {
    int tid_ = threadIdx.x; asm volatile("" : "+v"(tid_));
    const int tid = tid_, wid = __builtin_amdgcn_readfirstlane(tid >> 6), lane = tid & 63, wr = wid >> 2, wc = wid & 3, fr = lane & 15, fq = lane >> 4;
    const int K = S.kdim(), nt = K / BK;
    unsigned voffA[2], voffB[2];
#pragma unroll
    for (int i = 0; i < 2; ++i) { int R, C; stage_rc(tid * 16 + i * 8192, R, C); const int Rb = (R & ~31) + perm32(R & 31);
        voffA[i] = (unsigned)(R * K + C) * 2u; voffB[i] = (unsigned)(Rb * K + C) * 2u; }
    const size_t kstep = (size_t)(BK * 2);
    const size_t hstep = (size_t)HALF * K * 2;
    const unsigned ldsw = (unsigned)wid * 1024u;
    const int aoff = lds_byte(wr * 64 + fr, fq * 8), boff = lds_byte(wc * 32 + fr, fq * 8);
#define PG8_SA(b, h) (((b) * 2 + (h)) * HTB)
#define PG8_SB(b, h) ((4 + (b) * 2 + (h)) * HTB)
#define PG8_STAGE(bufoff, gbase, voff) do { _Pragma("unroll") for (int _i = 0; _i < 2; ++_i) \
        __builtin_amdgcn_global_load_lds((const unsigned*)((const char*)(gbase) + (voff)[_i]), (LAS unsigned*)(lds + (bufoff) + ldsw + _i * 8192), 16, 0, 0); } while (0)
#define PG8_LDA(dst, b, h) do { _Pragma("unroll") for (int m = 0; m < 4; ++m) _Pragma("unroll") for (int k = 0; k < 2; ++k) dst[m][k] = *(const LAS bf16x8*)(lds + PG8_SA(b, h) + aoff + m * 2048 + k * 1024); } while (0)
#define PG8_LDB(dst, b, h) do { _Pragma("unroll") for (int n = 0; n < 2; ++n) _Pragma("unroll") for (int k = 0; k < 2; ++k) dst[n][k] = *(const LAS bf16x8*)(lds + PG8_SB(b, h) + boff + n * 2048 + k * 1024); } while (0)
#define PG8_MMA(ai, bj, At, Bt) do { __builtin_amdgcn_s_setprio(1); _Pragma("unroll") for (int m = 0; m < 4; ++m) _Pragma("unroll") for (int n = 0; n < 2; ++n) _Pragma("unroll") for (int k = 0; k < 2; ++k) \
        acc[ai][bj][m][n] = __builtin_amdgcn_mfma_f32_16x16x32_bf16(Bt[n][k], At[m][k], acc[ai][bj][m][n], 0, 0, 0); __builtin_amdgcn_s_setprio(0); } while (0)
#define PG8_WAIT_V(n) asm volatile("s_waitcnt vmcnt(" #n ")" ::: "memory")
#define PG8_WAIT_L(n) asm volatile("s_waitcnt lgkmcnt(" #n ")" ::: "memory")
#define PG8_BAR __builtin_amdgcn_s_barrier()
#define PG8_SCHED __builtin_amdgcn_sched_barrier(0)
    Unit cur, nxt; int ui = 0;
    if (!S.next(0, cur)) return;
    f32x4 acc[2][2][4][2];
#pragma unroll
    for (int a = 0; a < 2; ++a)
#pragma unroll
        for (int b = 0; b < 2; ++b)
#pragma unroll
            for (int m = 0; m < 4; ++m)
#pragma unroll
                for (int n = 0; n < 2; ++n) acc[a][b][m][n] = (f32x4){0.f, 0.f, 0.f, 0.f};
    bf16x8 At[4][2], B0[2][2], B1[2][2];
    const char* cA = cur.a; const char* cB = cur.b;
    PG8_STAGE(PG8_SB(0, 0), cB, voffB); PG8_STAGE(PG8_SB(0, 1), cB + hstep, voffB); PG8_STAGE(PG8_SA(0, 0), cA, voffA); PG8_STAGE(PG8_SA(0, 1), cA + hstep, voffA);
    if (wr == 1) PG8_BAR;
    PG8_WAIT_V(2); PG8_BAR;
    PG8_STAGE(PG8_SB(1, 0), cB + kstep, voffB); PG8_STAGE(PG8_SA(1, 0), cA + kstep, voffA); PG8_STAGE(PG8_SB(1, 1), cB + hstep + kstep, voffB);
    PG8_WAIT_V(6); PG8_BAR;
    for (;;) {
        const bool has_next = S.next(ui + 1, nxt);
        const char* nA = has_next ? nxt.a : cA; const char* nB = has_next ? nxt.b : cB;
        for (int t = 0; t < nt; t += 2) {
            const bool last = (t == nt - 2);
            const char* a1 = cA + (size_t)(t + 1) * kstep;
            const char* a2 = last ? nA : cA + (size_t)(t + 2) * kstep; const char* b2 = last ? nB : cB + (size_t)(t + 2) * kstep;
            const char* a3 = a2 + kstep; const char* b3 = b2 + kstep;
            PG8_LDB(B0, 0, 0); PG8_LDB(B1, 0, 1); PG8_SCHED; PG8_LDA(At, 0, 0); PG8_STAGE(PG8_SA(1, 1), a1 + hstep, voffA);
            PG8_WAIT_V(8); PG8_WAIT_L(0); PG8_BAR; PG8_MMA(0, 0, At, B0); PG8_MMA(0, 1, At, B1); PG8_BAR; PG8_SCHED;
            PG8_LDA(At, 0, 1); PG8_STAGE(PG8_SB(0, 0), b2, voffB); PG8_STAGE(PG8_SB(0, 1), b2 + hstep, voffB); PG8_STAGE(PG8_SA(0, 0), a2, voffA);
            PG8_WAIT_V(8); PG8_WAIT_L(0); PG8_BAR; PG8_MMA(1, 0, At, B0); PG8_MMA(1, 1, At, B1); PG8_BAR; PG8_SCHED;
            PG8_LDB(B0, 1, 0); PG8_LDB(B1, 1, 1); PG8_SCHED; PG8_LDA(At, 1, 0); PG8_STAGE(PG8_SA(0, 1), a2 + hstep, voffA);
            PG8_WAIT_V(8); PG8_WAIT_L(0); PG8_BAR; PG8_MMA(0, 0, At, B0); PG8_MMA(0, 1, At, B1); PG8_BAR; PG8_SCHED;
            PG8_LDA(At, 1, 1); PG8_STAGE(PG8_SB(1, 0), b3, voffB); PG8_STAGE(PG8_SB(1, 1), b3 + hstep, voffB); PG8_STAGE(PG8_SA(1, 0), a3, voffA);
            PG8_WAIT_V(8); PG8_WAIT_L(0); PG8_BAR; PG8_MMA(1, 0, At, B0); PG8_MMA(1, 1, At, B1); PG8_BAR; PG8_SCHED;
        }
        if (wr == 0) PG8_BAR;
        E(acc, cur, wr, wc, fr, fq);
        if (!has_next) break;
#pragma unroll
        for (int a = 0; a < 2; ++a)
#pragma unroll
            for (int b = 0; b < 2; ++b)
#pragma unroll
                for (int m = 0; m < 4; ++m)
#pragma unroll
                    for (int n = 0; n < 2; ++n) acc[a][b][m][n] = (f32x4){0.f, 0.f, 0.f, 0.f};
        cur = nxt; cA = nA; cB = nB; ++ui;
        if (wr == 1) PG8_BAR;
    }
    PG8_WAIT_V(0);
    PG8_BAR;
#undef PG8_SA
#undef PG8_SB
#undef PG8_STAGE
#undef PG8_LDA
#undef PG8_LDB
#undef PG8_MMA
#undef PG8_WAIT_V
#undef PG8_WAIT_L
#undef PG8_BAR
#undef PG8_SCHED
}
}

namespace attn_body {
using bf16 = __hip_bfloat16;
constexpr int D = 64, NW = 8, QBLK = 32, QB = QBLK * NW, KVBLK = 64;
__device__ __forceinline__ int crow(int r, int hi) { return (r & 3) + 8 * (r >> 2) + 4 * hi; }
#define SBAR() __builtin_amdgcn_sched_barrier(0)
__device__ __forceinline__ void cmask(f32x16& p0, f32x16& p1, int jb, int qrel, int hi) {
    const float NEG = -INFINITY; int kb = 64 * jb + 4 * hi;
#pragma unroll
    for (int r = 0; r < 16; ++r) { int kv = kb + (r & 3) + 8 * (r >> 2); if (kv > qrel) p0[r] = NEG; if (kv + 32 > qrel) p1[r] = NEG; }
}
constexpr int NSLOT = 3, SLOTB = 8192;
constexpr int LDS_K = 0, LDS_V = NSLOT * SLOTB, LDS_WS = 2 * NSLOT * SLOTB, LDS_OST = LDS_WS + NW * 64 * 4, LDS_BYTES = LDS_OST + NW * 4096;
constexpr int LDS_C2 = 86016, LDS_C2T = 103424;
__device__ __forceinline__ void glds16(const void* gsrc, unsigned lds_dst) { unsigned keep;
    asm volatile("s_mov_b32 %0, m0\n\ts_mov_b32 m0, %2\n\ts_nop 0\n\tglobal_load_lds_dwordx4 %1, off\n\ts_mov_b32 m0, %0" : "=&s"(keep) : "v"(gsrc), "s"(lds_dst) : "memory"); }
__device__ __forceinline__ float max3f(float a, float b, float c) { float r; asm("v_max3_f32 %0, %1, %2, %3" : "=v"(r) : "v"(a), "v"(b), "v"(c)); return r; }
__device__ __forceinline__ float max2f(float a, float b) { float r; asm("v_max_f32_e32 %0, %1, %2" : "=v"(r) : "v"(a), "v"(b)); return r; }
__device__ __forceinline__ float fadd_s(float a, float b) { float r; asm("v_add_f32_e32 %0, %1, %2" : "=v"(r) : "v"(a), "v"(b)); return r; }
__device__ __forceinline__ float fsub_s(float a, float b) { float r; asm("v_sub_f32_e32 %0, %1, %2" : "=v"(r) : "v"(a), "v"(b)); return r; }
typedef float f32x2_t __attribute__((ext_vector_type(2))); typedef __bf16 bf16x2_t __attribute__((ext_vector_type(2)));
__device__ __forceinline__ unsigned cvtpk_s(float lo, float hi) { f32x2_t v = {lo, hi}; bf16x2_t b = __builtin_convertvector(v, bf16x2_t); return __builtin_bit_cast(unsigned, b); }
#define WAIT_BAR(N) asm volatile("s_waitcnt vmcnt(" #N ") lgkmcnt(0)\n\ts_barrier" ::: "memory")

__device__ __forceinline__ void qkt(f32x16& p0, f32x16& p1, const char* Kslot, const bf16x8* qr, const f32x16& negm, int r32, int hi) {
    const char* kb = Kslot + hi * 1024 + r32 * 16;
#pragma unroll
    for (int d0 = 0; d0 < 4; ++d0) {
        const bf16x8 b0 = *reinterpret_cast<const bf16x8*>(kb + d0 * 2048);
        const bf16x8 b1 = *reinterpret_cast<const bf16x8*>(kb + d0 * 2048 + 512);
        if (d0 == 0) { p0 = __builtin_amdgcn_mfma_f32_32x32x16_bf16(b0, qr[0], negm, 0, 0, 0); p1 = __builtin_amdgcn_mfma_f32_32x32x16_bf16(b1, qr[0], negm, 0, 0, 0); }
        else { p0 = __builtin_amdgcn_mfma_f32_32x32x16_bf16(b0, qr[d0], p0, 0, 0, 0); p1 = __builtin_amdgcn_mfma_f32_32x32x16_bf16(b1, qr[d0], p1, 0, 0, 0); } }
}
typedef __attribute__((address_space(3))) const char* lds_cptr;
typedef short v4i16_t __attribute__((ext_vector_type(4)));
__device__ __forceinline__ void kload8(bf16x8* kf, lds_cptr kp) {
    kf[0] = *(const LAS bf16x8*)(kp);        kf[1] = *(const LAS bf16x8*)(kp + 512);
    kf[2] = *(const LAS bf16x8*)(kp + 2048); kf[3] = *(const LAS bf16x8*)(kp + 2560);
    kf[4] = *(const LAS bf16x8*)(kp + 4096); kf[5] = *(const LAS bf16x8*)(kp + 4608);
    kf[6] = *(const LAS bf16x8*)(kp + 6144); kf[7] = *(const LAS bf16x8*)(kp + 6656);
}
__device__ __forceinline__ void kload2(bf16x8* kf, lds_cptr kp, int j) { kf[2 * j] = *(const LAS bf16x8*)(kp + j * 2048); kf[2 * j + 1] = *(const LAS bf16x8*)(kp + j * 2048 + 512); }
__device__ __forceinline__ s16x4 vtr(lds_cptr p) { return __builtin_bit_cast(s16x4, __builtin_amdgcn_ds_read_tr16_b64_v4i16((LAS v4i16_t*)p)); }
__device__ __forceinline__ float rowmax(const f32x16& p0, const f32x16& p1) {
    float a = max3f(p0[0], p0[1], p1[0]), b = max3f(p0[2], p0[3], p1[1]); a = max3f(a, p1[2], p1[3]);
#pragma unroll
    for (int r = 4; r < 16; r += 4) { a = max3f(a, p0[r], p0[r + 1]); b = max3f(b, p0[r + 2], p0[r + 3]); a = max3f(a, p1[r], p1[r + 1]); b = max3f(b, p1[r + 2], p1[r + 3]); }
    const float m = max2f(a, b);
    auto rr = __builtin_amdgcn_permlane32_swap(__float_as_uint(m), __float_as_uint(m), false, false);
    return max2f(__uint_as_float(rr[0]), __uint_as_float(rr[1]));
}
__device__ __forceinline__ void pv(f32x16* o, int vb, bf16x8 pa0, bf16x8 pa1, bf16x8 pa2, bf16x8 pa3) {
#pragma unroll
    for (int d0 = 0; d0 < 2; ++d0) { s16x4 lo[4], hi[4];
#pragma unroll
        for (int ks = 0; ks < 4; ++ks) {
            asm volatile("ds_read_b64_tr_b16 %0,%1 offset:%c2" : "=&v"(lo[ks]) : "v"(vb), "i"(d0 * 4096 + ks * 1024) : "memory");
            asm volatile("ds_read_b64_tr_b16 %0,%1 offset:%c2" : "=&v"(hi[ks]) : "v"(vb), "i"(d0 * 4096 + ks * 1024 + 512) : "memory"); }
        asm volatile("s_waitcnt lgkmcnt(0)" ::: "memory"); SBAR();
#define PK(k) (bf16x8){lo[k][0], lo[k][1], lo[k][2], lo[k][3], hi[k][0], hi[k][1], hi[k][2], hi[k][3]}
        o[d0] = __builtin_amdgcn_mfma_f32_32x32x16_bf16(pa0, PK(0), o[d0], 0, 0, 0);
        o[d0] = __builtin_amdgcn_mfma_f32_32x32x16_bf16(pa1, PK(1), o[d0], 0, 0, 0);
        o[d0] = __builtin_amdgcn_mfma_f32_32x32x16_bf16(pa2, PK(2), o[d0], 0, 0, 0);
        o[d0] = __builtin_amdgcn_mfma_f32_32x32x16_bf16(pa3, PK(3), o[d0], 0, 0, 0);
#undef PK
    }
}

template <int THRL, bool DRY> __device__ __forceinline__ void attn_unit(int b, int h, int qb, const bf16* Q, const bf16* __restrict__ K, const bf16* __restrict__ V, const bf16* __restrict__ KL, const bf16* __restrict__ VL, bf16* O, const float* __restrict__ C2, char* shm) {
    int tid_ = threadIdx.x; asm volatile("" : "+v"(tid_));
    const int tid = tid_, lane = tid & 63, r32 = lane & 31, hi = lane >> 5; const int wid = __builtin_amdgcn_readfirstlane(tid >> 6);
    const long rowbase = (long)b * PP; const int q0 = 128 + qb * QB;
    const bf16* Qw = Q + (rowbase + q0 + wid * QBLK) * DM + h * D;
    const bf16* Kh = K + (rowbase + 64) * DM + h * D, *Vh = V + (rowbase + 64) * DM + h * D;
    const unsigned lds0 = (unsigned)(uintptr_t)shm;
    float* wsf = (float*)(shm + LDS_WS) + wid * 64;
    const int NT = 6 + 4 * qb, NTR = NT - 1;
    const lds_cptr shm3 = (lds_cptr)shm;
    const float* c2g = C2 + ((size_t)(b * 16 + h)) * PP + 64;
    { LAS float* c2w = (LAS float*)(shm3 + LDS_C2); LAS float* c2tw = (LAS float*)(shm3 + LDS_C2T);
      for (int i = tid; i < 64 * NT; i += 512) c2w[i] = (i < 64 * NTR) ? (c2g[i] - c2g[i | 63]) : 0.f;
      if (tid < NT) c2tw[tid] = (tid < NTR) ? c2g[64 * tid + 63] : 0.f; }
    const float c2q = c2g[q0 - 64 + wid * QBLK + r32];
    const LAS float* c2s = (const LAS float*)(shm3 + LDS_C2) + 4 * hi;
    const LAS float* c2t = (const LAS float*)(shm3 + LDS_C2T);
    const bf16* ksrc = Kh + (long)lane * DM + wid * 8;
    const bf16* vsrc = Vh + (long)(16 * (wid & 3) + (lane >> 2)) * DM + (wid >> 2) * 32 + (lane & 3) * 8;
    const unsigned kdst = lds0 + LDS_K + wid * 1024, vdst = lds0 + LDS_V + wid * 1024;
#define TCL(t) (((t) < NTR) ? (t) : (NTR - 1))
#define DMA_K(t, slot) glds16(ksrc + (long)TCL(t) * KVBLK * DM, (unsigned)__builtin_amdgcn_readfirstlane(kdst + (slot)))
#define DMA_V(t, slot) glds16(vsrc + (long)TCL(t) * KVBLK * DM, (unsigned)__builtin_amdgcn_readfirstlane(vdst + (slot)))
    const int vb0 = (int)(lds0 + LDS_V) + ((lane >> 4) & 1) * 32 + (lane & 3) * 8 + (4 * hi + ((lane & 15) >> 2)) * 64;
    const char* Kbase = shm + LDS_K; bf16x8 kf[8];
    const lds_cptr kp0 = shm3 + LDS_K + hi * 1024 + r32 * 16; const lds_cptr vp0 = shm3 + LDS_V + ((lane >> 4) & 1) * 32 + (lane & 3) * 8 + (4 * hi + ((lane & 15) >> 2)) * 64;
    glds16(KL + (long)(64 + lane) * DM + h * D + wid * 8, (unsigned)__builtin_amdgcn_readfirstlane(kdst));
    glds16(VL + (long)(64 + 16 * (wid & 3) + (lane >> 2)) * DM + h * D + (wid >> 2) * 32 + (lane & 3) * 8, (unsigned)__builtin_amdgcn_readfirstlane(vdst));
    DMA_K(1, SLOTB);
    bf16x8 qr[4];
#pragma unroll
    for (int d0 = 0; d0 < 4; ++d0) qr[d0] = *reinterpret_cast<const bf16x8*>(&Qw[(long)r32 * DM + d0 * 16 + hi * 8]);
    float l_reg = 0.f; f32x16 o[2]; o[0] = f32x16{}; o[1] = f32x16{}; const f32x16 negm = f32x16{}; float moff = 0.f, mq = 0.f;
    const int qrel = wid * QBLK + r32;
#define CMASK(P0, P1, t) do { int jb_ = (t) - (NT - 5); if (jb_ >= 0) cmask(P0, P1, jb_, qrel, hi); } while (0)
    bool resc = false;
#define EXD(P, OFF) do { _Pragma("unroll") for (int g_ = 0; g_ < 4; ++g_) { const f32x4 dk_ = *(const LAS f32x4*)(c2s + (OFF) + 8 * g_); \
      _Pragma("unroll") for (int i_ = 0; i_ < 4; ++i_) P[4 * g_ + i_] = __builtin_amdgcn_exp2f((P[4 * g_ + i_] - moff) - dk_[i_]); } } while (0)
#define START(P0, P1) do { const float rmr = rowmax(P0, P1); resc = false; \
    mq = rmr - c2t[0]; moff = rmr; \
    EXD(P0, 0); } while (0)
#define RESC() do { if (resc) { asm volatile("s_waitcnt lgkmcnt(0)" ::: "memory"); \
      _Pragma("unroll") for (int d_ = 0; d_ < 2; ++d_) _Pragma("unroll") for (int r = 0; r < 16; ++r) o[d_][r] *= wsf[crow(r, hi)]; } } while (0)
    f32x16 pA0, pA1, pB0, pB1;
    int sl_prev = 0, sl_cur = 0, sl_next = SLOTB;
#define ROT() do { sl_prev = sl_cur; sl_cur = sl_next; sl_next = (sl_next == (NSLOT - 1) * SLOTB) ? 0 : sl_next + SLOTB; } while (0)
    DMA_K(2, 2 * SLOTB);
    WAIT_BAR(3);
    qkt(pA0, pA1, Kbase, qr, negm, r32, hi); asm volatile("s_nop 15\n\ts_nop 7" : "+v"(pA0), "+v"(pA1)); CMASK(pA0, pA1, 0);
    START(pA0, pA1);
    EXD(pA1, 32);
    WAIT_BAR(0);
    DMA_K(3, 0); DMA_V(1, SLOTB);
    ROT();
    kload8(kf, kp0 + sl_cur);
    WAIT_BAR(2);
    s16x4 vlo[8], vhi[8]; u32x4 pw0, pw1, pw2, pw3;
#define PKW(P, B) cvtpk_s(P[B], P[B + 1])
#define PAF(k) __builtin_bit_cast(bf16x8, pw##k)
#define VFR(i) (bf16x8){vlo[i][0], vlo[i][1], vlo[i][2], vlo[i][3], vhi[i][0], vhi[i][1], vhi[i][2], vhi[i][3]}
#define PIN(x) asm volatile("" : "+v"(x))
#define MX3(a, b, c) __builtin_fmaxf(__builtin_fmaxf((a), (b)), (c))
#define GAPA(MF, A0, A1, A2, A3, W0, W1, PW) do { MF; sacc += A0; sacc += A1; sacc += A2; sacc += A3; PIN(sacc); W0; W1; PIN(PW); SBAR(); } while (0)
#define EX(v) __builtin_amdgcn_exp2f(v)
#define DKR(OFF) (*(const LAS f32x4*)(dkp_ + (OFF)))
#define GAPB(MF, X, B, DKC, DKN, OFFN) do { MF; DKN = DKR(OFFN); X[B] = EX((X[B] - moff) - DKC[0]); X[B + 1] = EX((X[B + 1] - moff) - DKC[1]); X[B + 2] = EX((X[B + 2] - moff) - DKC[2]); X[B + 3] = EX((X[B + 3] - moff) - DKC[3]); PIN(X); SBAR(); } while (0)
#define VRD(i) do { vlo[i] = vtr(vp_ + (((i) >> 2) * 4096 + ((i) & 3) * 1024)); vhi[i] = vtr(vp_ + (((i) >> 2) * 4096 + ((i) & 3) * 1024 + 512)); } while (0)
#define KRD(G, j) do { if (G) { kload2(kf, kp0 + sl_next, j); SBAR(); } } while (0)
#define STEP(C0, C1, P0, P1, t, GK, GV, GL) do { SBAR(); \
    const lds_cptr vp_ = vp0 + sl_prev; \
    VRD(0); SBAR(); float sacc = (P0[0] + P0[1]); \
    GAPA(C0 = __builtin_amdgcn_mfma_f32_32x32x16_bf16(kf[0], qr[0], negm, 0, 0, 0), P0[2], P0[3], P0[4], P0[5],     pw0[0] = PKW(P0, 0), pw0[1] = PKW(P0, 2), pw0); \
    VRD(4); SBAR(); GAPA(C1 = __builtin_amdgcn_mfma_f32_32x32x16_bf16(kf[1], qr[0], negm, 0, 0, 0), P0[6], P0[7], P0[8], P0[9],     pw0[2] = PKW(P0, 4), pw0[3] = PKW(P0, 6), pw0); \
    VRD(1); SBAR(); GAPA(C0 = __builtin_amdgcn_mfma_f32_32x32x16_bf16(kf[2], qr[1], C0, 0, 0, 0),   P0[10], P0[11], P0[12], P0[13], pw1[0] = PKW(P0, 8), pw1[1] = PKW(P0, 10), pw1); \
    VRD(5); SBAR(); GAPA(C1 = __builtin_amdgcn_mfma_f32_32x32x16_bf16(kf[3], qr[1], C1, 0, 0, 0),   P0[14], P0[15], P1[0], P1[1],   pw1[2] = PKW(P0, 12), pw1[3] = PKW(P0, 14), pw1); \
    VRD(2); SBAR(); GAPA(C0 = __builtin_amdgcn_mfma_f32_32x32x16_bf16(kf[4], qr[2], C0, 0, 0, 0),   P1[2], P1[3], P1[4], P1[5],     pw2[0] = PKW(P1, 0), pw2[1] = PKW(P1, 2), pw2); \
    VRD(6); SBAR(); GAPA(C1 = __builtin_amdgcn_mfma_f32_32x32x16_bf16(kf[5], qr[2], C1, 0, 0, 0),   P1[6], P1[7], P1[8], P1[9],     pw2[2] = PKW(P1, 4), pw2[3] = PKW(P1, 6), pw2); \
    VRD(3); SBAR(); GAPA(C0 = __builtin_amdgcn_mfma_f32_32x32x16_bf16(kf[6], qr[3], C0, 0, 0, 0),   P1[10], P1[11], P1[12], P1[13], pw3[0] = PKW(P1, 8), pw3[1] = PKW(P1, 10), pw3); \
    VRD(7); SBAR(); GAPA(C1 = __builtin_amdgcn_mfma_f32_32x32x16_bf16(kf[7], qr[3], C1, 0, 0, 0),   P1[14], P1[15], 0.f, 0.f,       pw3[2] = PKW(P1, 12), pw3[3] = PKW(P1, 14), pw3); \
    l_reg += sacc; \
    if (GK) { DMA_K((t) + 3, sl_cur); } if (GV) { DMA_V((t) + 1, sl_next); } \
    CMASK(C0, C1, t); \
    const LAS float* dkp_ = c2s + 64 * (t); f32x4 dkA_ = DKR(0), dkB_; \
    { float a = MX3(C0[0], C0[1], C1[0]), b = MX3(C0[2], C0[3], C1[1]); a = MX3(a, C1[2], C1[3]); \
      _Pragma("unroll") for (int r = 4; r < 16; r += 4) { a = MX3(a, C0[r], C0[r + 1]); b = MX3(b, C0[r + 2], C0[r + 3]); a = MX3(a, C1[r], C1[r + 1]); b = MX3(b, C1[r + 2], C1[r + 3]); } \
      float rm = __builtin_fmaxf(a, b); { auto rr = __builtin_amdgcn_permlane32_swap(__float_as_uint(rm), __float_as_uint(rm), false, false); rm = __builtin_fmaxf(__uint_as_float(rr[0]), __uint_as_float(rr[1])); } \
      moff = mq + c2t[t]; rm -= moff; \
      resc = false; \
      if (__builtin_expect(__any(rm > (float)THRL), 0)) { const float dl = __builtin_fmaxf(rm, 0.f); mq += dl; moff += dl; \
        const float f = __builtin_amdgcn_exp2f(-dl); l_reg *= f; if (hi == 0) wsf[r32] = f; resc = true; } } \
    SBAR(); \
    GAPB(o[0] = __builtin_amdgcn_mfma_f32_32x32x16_bf16(PAF(0), VFR(0), o[0], 0, 0, 0), C0, 0, dkA_, dkB_, 8); \
    GAPB(o[1] = __builtin_amdgcn_mfma_f32_32x32x16_bf16(PAF(0), VFR(4), o[1], 0, 0, 0), C0, 4, dkB_, dkA_, 16); \
    KRD(GL, 0); GAPB(o[0] = __builtin_amdgcn_mfma_f32_32x32x16_bf16(PAF(1), VFR(1), o[0], 0, 0, 0), C0, 8, dkA_, dkB_, 24); \
    KRD(GL, 1); GAPB(o[1] = __builtin_amdgcn_mfma_f32_32x32x16_bf16(PAF(1), VFR(5), o[1], 0, 0, 0), C0, 12, dkB_, dkA_, 32); \
    KRD(GL, 2); GAPB(o[0] = __builtin_amdgcn_mfma_f32_32x32x16_bf16(PAF(2), VFR(2), o[0], 0, 0, 0), C1, 0, dkA_, dkB_, 40); \
    KRD(GL, 3); GAPB(o[1] = __builtin_amdgcn_mfma_f32_32x32x16_bf16(PAF(2), VFR(6), o[1], 0, 0, 0), C1, 4, dkB_, dkA_, 48); \
    GAPB(o[0] = __builtin_amdgcn_mfma_f32_32x32x16_bf16(PAF(3), VFR(3), o[0], 0, 0, 0), C1, 8, dkA_, dkB_, 56); \
    GAPB(o[1] = __builtin_amdgcn_mfma_f32_32x32x16_bf16(PAF(3), VFR(7), o[1], 0, 0, 0), C1, 12, dkB_, dkA_, 56); \
    } while (0)
    int t = 1;
#undef CMASK
#define CMASK(P0, P1, t) do { } while (0)
    for (; t + 6 < NT; t += 2) {
        STEP(pB0, pB1, pA0, pA1, t, true, true, true);     WAIT_BAR(2); RESC(); ROT();
        STEP(pA0, pA1, pB0, pB1, t + 1, true, true, true); WAIT_BAR(2); RESC(); ROT();
    }
#undef CMASK
#define CMASK(P0, P1, t) do { int jb_ = (t) - (NT - 5); if (jb_ >= 0) cmask(P0, P1, jb_, qrel, hi); } while (0)
#define ENDW(tt) do { if ((tt) + 3 < NT) { WAIT_BAR(2); } else if ((tt) + 2 < NT) { WAIT_BAR(1); } else { WAIT_BAR(0); } } while (0)
    for (; t + 1 < NT; t += 2) {
        STEP(pB0, pB1, pA0, pA1, t, (t + 3 < NT), (t + 1 < NT), (t + 1 < NT));         ENDW(t);     RESC(); ROT();
        STEP(pA0, pA1, pB0, pB1, t + 1, (t + 4 < NT), (t + 2 < NT), (t + 2 < NT));     ENDW(t + 1); RESC(); ROT();
    }
    STEP(pB0, pB1, pA0, pA1, NT - 1, false, false, false); RESC();
    { float sacc = pB0[0] + pB0[1]; _Pragma("unroll") for (int r = 2; r < 16; ++r) sacc += pB0[r]; _Pragma("unroll") for (int r = 0; r < 16; ++r) sacc += pB1[r]; l_reg += sacc;
      pw0 = (u32x4){PKW(pB0, 0), PKW(pB0, 2), PKW(pB0, 4), PKW(pB0, 6)}; pw1 = (u32x4){PKW(pB0, 8), PKW(pB0, 10), PKW(pB0, 12), PKW(pB0, 14)}; pw2 = (u32x4){PKW(pB1, 0), PKW(pB1, 2), PKW(pB1, 4), PKW(pB1, 6)}; pw3 = (u32x4){PKW(pB1, 8), PKW(pB1, 10), PKW(pB1, 12), PKW(pB1, 14)};
      SBAR(); pv(o, vb0 + sl_cur, PAF(0), PAF(1), PAF(2), PAF(3)); }
#undef PKW
#undef PAF
#undef VFR
#undef PIN
#undef MX3
#undef GAPA
#undef GAPB
#undef EX
#undef DKR
#undef VRD
#undef KRD
#undef STEP
#undef ENDW
    { auto rr = __builtin_amdgcn_permlane32_swap(__float_as_uint(l_reg), __float_as_uint(l_reg), false, false); l_reg = __uint_as_float(rr[0]) + __uint_as_float(rr[1]); }
    if (hi == 0) wsf[32 + r32] = l_reg; asm volatile("s_waitcnt lgkmcnt(0)" ::: "memory");
    float rli[16];
#pragma unroll
    for (int r = 0; r < 16; ++r) rli[r] = __builtin_amdgcn_rcpf(wsf[32 + crow(r, hi)]);
    bf16* Ow = O + (rowbase + q0 + wid * QBLK) * DM + h * D;
    { bf16* stg = (bf16*)(shm + LDS_OST) + wid * 2048;
#pragma unroll
      for (int r = 0; r < 16; ++r) { const int orow = crow(r, hi);
#pragma unroll
        for (int d0 = 0; d0 < 2; ++d0) stg[orow * 64 + d0 * 32 + r32] = __float2bfloat16(o[d0][r] * rli[r]); }
      asm volatile("s_waitcnt lgkmcnt(0)" ::: "memory");
#pragma unroll
      for (int i = 0; i < 4; ++i) { const int row = i * 8 + (lane >> 3), ch = lane & 7; const u32x4 v = *(const u32x4*)(stg + row * 64 + ch * 8); if (!DRY || v.x == 0x12345679u) *(u32x4*)(Ow + (long)row * DM + ch * 8) = v; } }
    asm volatile("s_waitcnt lgkmcnt(0)\n\ts_barrier" ::: "memory");
#undef DMA_K
#undef DMA_V
#undef TCL
#undef CMASK
#undef EXD
#undef START
#undef RESC
#undef ROT
}
#undef SBAR
#undef WAIT_BAR
}

constexpr int RING_BYTES = 131072;
constexpr int LDS_BYTES = 147456;

__device__ __forceinline__ void tr_item(const float* W, int ldw, int K, int k0, int nvalid, const float* gain, bf16_t* dst, LAS float* scr, int lane) {
    float tv[32];
#pragma unroll
    for (int i = 0; i < 32; ++i) { const int kk = 2 * i + (lane >> 5), c = lane & 31; tv[i] = (c < nvalid) ? W[(size_t)(k0 + kk) * ldw + c] : 0.f; }
#pragma unroll
    for (int i = 0; i < 32; ++i) { const int kk = 2 * i + (lane >> 5), c = lane & 31; float v = tv[i]; if (gain) v *= gain[k0 + kk]; scr[kk * 33 + c] = v; }
    LDS_WAIT(); asm volatile("" ::: "memory");
    const int c8 = lane & 7;
#pragma unroll
    for (int j = 0; j < 4; ++j) { const int n = (lane >> 3) + 8 * j; const LAS float* s = scr + (8 * c8) * 33 + n;
        u32x4 o; o.x = cvt_pk_bf16(s[0 * 33], s[1 * 33]); o.y = cvt_pk_bf16(s[2 * 33], s[3 * 33]); o.z = cvt_pk_bf16(s[4 * 33], s[5 * 33]); o.w = cvt_pk_bf16(s[6 * 33], s[7 * 33]);
        *(u32x4*)(dst + (size_t)n * K + k0 + 8 * c8) = o; }
    LDS_WAIT(); asm volatile("" ::: "memory");
}
enum MapMode { MAP_ID = 0, MAP_SWA, MAP_SWB, MAP_H64, MAP_ROT };
__device__ __forceinline__ int map_row(int mode, int nb) {
    const int c = 32 * nb;
    switch (mode) {
        case MAP_SWA: return 256 * (c >> 7) + (c & 127);
        case MAP_SWB: return 256 * (c >> 7) + 128 + (c & 127);
        case MAP_H64: { const int tl = c >> 8, ob = (c & 255) >> 5; return 256 * tl + 128 * (ob & 1) + 32 * (ob >> 1); }
        case MAP_ROT: { const int tl = c >> 8, ob = (c & 255) >> 5; return 256 * tl + 128 * ((ob >> 1) & 1) + 64 * (ob >> 2) + 32 * (ob & 1); }
        default: return c;
    }
}
struct Seg { const float* W; int ldw, K, ncols; const float* gain; size_t dst; int dstrow, mode; };
__device__ __forceinline__ Seg get_seg(const Params& p, int s) {
    switch (s) {
        case 0: return Seg{p.w1i, 2 * DFF, 1024, DFF, p.n1, WS_W1A, 0, MAP_SWA};
        case 1: return Seg{p.w1i + DFF, 2 * DFF, 1024, DFF, p.n1, WS_W1A, 0, MAP_SWB};
        case 2: return Seg{p.w1o, 1024, DFF, 1024, nullptr, WS_W1B, 0, MAP_ID};
        case 3: return Seg{p.win + 0, NINC, 1024, 1024, p.nm, WS_WIN, WIN_FOX, MAP_H64};
        case 4: return Seg{p.win + 1024, NINC, 1024, 1024, p.nm, WS_WIN, WIN_FOX + 1024, MAP_H64};
        case 5: return Seg{p.win + 2048, NINC, 1024, 1024, p.nm, WS_WIN, WIN_FOX + 2048, MAP_ID};
        case 6: return Seg{p.win + 3072, NINC, 1024, 16, p.nm, WS_WIN, WIN_RET + 3072, MAP_ID};
        case 7: return Seg{p.win + 3088, NINC, 1024, 512, p.nm, WS_WIN, WIN_RET + 0, MAP_ROT};
        case 8: return Seg{p.win + 3600, NINC, 1024, 512, p.nm, WS_WIN, WIN_RET + 512, MAP_ROT};
        case 9: return Seg{p.win + 4112, NINC, 1024, 1024, p.nm, WS_WIN, WIN_RET + 1024, MAP_ID};
        case 10: return Seg{p.win + 5136, NINC, 1024, 1024, p.nm, WS_WIN, WIN_RET + 2048, MAP_ID};
        case 11: return Seg{p.win + 6160, NINC, 1024, 1024, p.nm, WS_WIN, WIN_GA, MAP_ID};
        case 12: return Seg{p.win + 7184, NINC, 1024, 1024, p.nm, WS_WIN, WIN_GB, MAP_ID};
        case 13: return Seg{p.wof, 1024, 1024, 1024, nullptr, WS_WOF, 0, MAP_ID};
        case 14: return Seg{p.wor, 1024, 1024, 1024, nullptr, WS_WOR, 0, MAP_ID};
        case 15: return Seg{p.wout, 1024, 1024, 1024, nullptr, WS_WOUT, 0, MAP_ID};
        case 16: return Seg{p.w2i, 2 * DFF, 1024, DFF, p.n2, WS_W2A, 0, MAP_SWA};
        case 17: return Seg{p.w2i + DFF, 2 * DFF, 1024, DFF, p.n2, WS_W2A, 0, MAP_SWB};
        default: return Seg{p.w2o, 1024, DFF, 1024, nullptr, WS_W2B, 0, MAP_ID};
    }
}
__device__ __forceinline__ int seg_items(int s) {
    switch (s) {
        case 0: case 1: case 16: case 17: return 16 * 88;
        case 2: case 18: return 44 * 32;
        case 6: return 16;
        case 7: case 8: return 16 * 16;
        default: return 16 * 32;
    }
}
__device__ __forceinline__ void convert_range(const Params& p, LAS float* scr, int s_lo, int s_hi, int worker, int nworkers, int lane) {
    int total = 0;
#pragma unroll 1
    for (int s = s_lo; s <= s_hi; ++s) total += seg_items(s);
#pragma unroll 1
    for (int it = worker; it < total; it += nworkers) {
        int r = it, s = s_lo;
        while (r >= seg_items(s)) { r -= seg_items(s); ++s; }
        const Seg sg = get_seg(p, s);
        const int nblk = (sg.ncols + 31) / 32, kb = r / nblk, nb = r % nblk;
        const int nvalid = sg.ncols - 32 * nb < 32 ? sg.ncols - 32 * nb : 32;
        bf16_t* dst = (bf16_t*)(p.ws + sg.dst) + (size_t)(sg.dstrow + map_row(sg.mode, nb)) * sg.K;
        tr_item(sg.W + 32 * nb, sg.ldw, sg.K, 64 * kb, nvalid, sg.gain, dst, scr, lane);
    }
}
__device__ __forceinline__ void p0_prologue(const KP kp_, LAS unsigned char* lds, int vcu, int G, int tid, int wid, int lane) {
    const Params p = ldp(kp_);
    LAS float* scr = (LAS float*)(lds + wid * 16384);
    const int gw = vcu * 8 + wid, NGW = G * 8;
    convert_range(p, scr, 0, 1, gw, NGW, lane);
    { u32x4* z = (u32x4*)((bf16_t*)(p.ws + WS_WIN) + (size_t)(WIN_RET + 3072 + 32) * 1024); const int nz = 224 * 1024 * 2 / 16;
      for (int i = (vcu * 512 + tid); i < nz; i += G * 512) z[i] = (u32x4){0u, 0u, 0u, 0u}; }
    { bf16_t* XB = (bf16_t*)(p.ws + WS_XB); float* S0 = (float*)(p.ws + WS_SSQ0);
      for (int row0 = gw; row0 < MP; row0 += 2 * NGW) {
        f32x4 v[2][4]; float s[2];
#pragma unroll
        for (int h = 0; h < 2; ++h) { const int row = row0 + h * NGW; const int b = row / PP, pidx = row - b * PP;
#pragma unroll
            for (int j = 0; j < 4; ++j) { v[h][j] = (f32x4){0.f, 0.f, 0.f, 0.f};
                if (row < MP) { if (pidx >= 128) v[h][j] = *((const f32x4*)(p.x + ((size_t)(b * SEQ + pidx - 128)) * DM) + lane + 64 * j);
                    else if (pidx >= 112) v[h][j] = *((const f32x4*)(p.meta + (size_t)(pidx - 112) * DM) + lane + 64 * j); } } }
#pragma unroll
        for (int h = 0; h < 2; ++h) { s[h] = 0.f;
#pragma unroll
            for (int j = 0; j < 4; ++j) s[h] += (v[h][j][0] * v[h][j][0] + v[h][j][1] * v[h][j][1]) + (v[h][j][2] * v[h][j][2] + v[h][j][3] * v[h][j][3]);
            s[h] = wave_sum(s[h]); }
#pragma unroll
        for (int h = 0; h < 2; ++h) { const int row = row0 + h * NGW; if (row < MP) {
            u32x2* o8 = (u32x2*)(XB + (size_t)row * DM) + lane;
#pragma unroll
            for (int j = 0; j < 4; ++j) o8[64 * j] = pack4(v[h][j]);
            if (lane < 16) S0[(size_t)row * 16 + lane] = (lane == 0) ? s[h] : 0.f; } } } }
    { float* S1 = (float*)(p.ws + WS_SSQ1); for (int i = vcu * 512 + tid; i < NB * 2048; i += G * 512) S1[(size_t)(i >> 11) * PP * 16 + (i & 2047)] = 0.f; }
    { float* COS = (float*)(p.ws + WS_COS); float* SIN = (float*)(p.ws + WS_SIN);
      for (int i = vcu * 512 + tid; i < PP * 64; i += G * 512) { const int pidx = i >> 6, fi = i & 63;
        const float inv = exp2f(-(float)fi * (13.287712379549449f / 64.0f));
        const float ang = (float)(pidx - 112) * inv;
        const double a = (double)ang; const double kq = rint(a * 0.15915494309189535); const float red = (float)(a - kq * 6.283185307179586);
        COS[i] = __cosf(red); SIN[i] = __sinf(red); } }
}

__device__ __forceinline__ void thin_g2(const KP kp_, LAS unsigned char* lds, int bx, int wid, int lane) {
    if (bx >= 64) return;
    const Params p = ldp(kp_);
    const int l15 = lane & 15, g = lane >> 4, tile = bx, n0 = tile * 16;
    const bf16_t* wp = (const bf16_t*)(p.ws + WS_W1B) + (size_t)(n0 + l15) * DFF + 352 * wid + 8 * g;
    const bf16_t* hp = (const bf16_t*)(p.ws + WS_HID) + (size_t)(112 + l15) * DFF + 352 * wid + 8 * g;
    f32x4 acc = (f32x4){0.f, 0.f, 0.f, 0.f};
    bf16x8 a[11], b[11];
#pragma unroll
    for (int i = 0; i < 11; ++i) { a[i] = *(const bf16x8*)(wp + 32 * i); b[i] = *(const bf16x8*)(hp + 32 * i); }
#pragma unroll
    for (int i = 0; i < 11; ++i) acc = __builtin_amdgcn_mfma_f32_16x16x32_bf16(a[i], b[i], acc, 0, 0, 0);
    LAS f32x4* part = (LAS f32x4*)lds;
    part[wid * 64 + lane] = acc;
    __syncthreads();
    if (wid == 0) {
#pragma unroll
        for (int w = 1; w < 8; ++w) acc += part[w * 64 + lane];
        const f32x4 base = *(const f32x4*)(p.meta + (size_t)l15 * DM + n0 + 4 * g);
        const f32x4 h = base + acc * 0.5f;
        float ss = (h[0] * h[0] + h[1] * h[1]) + (h[2] * h[2] + h[3] * h[3]);
        ss += __shfl_xor(ss, 16); ss += __shfl_xor(ss, 32);
        bf16_t* HB = (bf16_t*)(p.ws + WS_XB); float* S1 = (float*)(p.ws + WS_SSQ1);
#pragma unroll
        for (int bb = 0; bb < NB; ++bb) { const size_t row = (size_t)bb * PP + 112 + l15;
            *(u32x2*)(HB + row * DM + n0 + 4 * g) = pack4(h);
            if (g == 0) atomicAdd(S1 + row * 16 + (tile & 15), ss); }
    }
    __syncthreads();
}

__device__ __forceinline__ float lg2gamma(int hd) { return log2f(1.0f - exp2f(-5.0f - (float)hd)); }
__device__ __forceinline__ void ret_kv_phase(const KP kp_, int vcu, int G, int wid, int lane) {
    const Params p = ldp(kp_);
    const bf16_t* KT = (const bf16_t*)(p.ws + WS_KT); const bf16_t* VT = (const bf16_t*)(p.ws + WS_VT); bf16_t* KVR = (bf16_t*)(p.ws + WS_KVR);
    const int l15 = lane & 15, g = lane >> 4;
#pragma unroll 1
    for (int u = vcu; u < 16 * 32; u += G) {
        const int bh = u >> 5, c = u & 31, hd = bh & 3; const float lg = lg2gamma(hd);
        const int bhs = (c == 0) ? hd : bh;
        f32x4 acc[2][8];
#pragma unroll
        for (int a = 0; a < 2; ++a)
#pragma unroll
            for (int b = 0; b < 8; ++b) acc[a][b] = (f32x4){0.f, 0.f, 0.f, 0.f};
#pragma unroll 1
        for (int s = 0; s < 4; ++s) {
            const int ml = 32 * s + 8 * g, m0 = 128 * c + ml;
            bf16x8 a[2]; u32x4 raw[2]; bf16x8 bfr[8];
#pragma unroll
            for (int ti = 0; ti < 2; ++ti) raw[ti] = *(const u32x4*)(VT + ((size_t)(bhs * 256 + 32 * wid + 16 * ti + l15)) * PP + m0);
#pragma unroll
            for (int tj = 0; tj < 8; ++tj) bfr[tj] = *(const bf16x8*)(KT + ((size_t)(bhs * 128 + 16 * tj + l15)) * PP + m0);
            asm volatile("" ::: "memory");
            float z[8];
#pragma unroll
            for (int j = 0; j < 8; ++j) z[j] = exp2f(lg * (float)(127 - (ml + j)));
#pragma unroll
            for (int ti = 0; ti < 2; ++ti) { u32x4 w; w.x = cvt_pk_bf16(bf_lo(raw[ti].x) * z[0], bf_hi(raw[ti].x) * z[1]); w.y = cvt_pk_bf16(bf_lo(raw[ti].y) * z[2], bf_hi(raw[ti].y) * z[3]);
                w.z = cvt_pk_bf16(bf_lo(raw[ti].z) * z[4], bf_hi(raw[ti].z) * z[5]); w.w = cvt_pk_bf16(bf_lo(raw[ti].w) * z[6], bf_hi(raw[ti].w) * z[7]);
                a[ti] = __builtin_bit_cast(bf16x8, w); }
#pragma unroll
            for (int tj = 0; tj < 8; ++tj) {
                acc[0][tj] = __builtin_amdgcn_mfma_f32_16x16x32_bf16(bfr[tj], a[0], acc[0][tj], 0, 0, 0);
                acc[1][tj] = __builtin_amdgcn_mfma_f32_16x16x32_bf16(bfr[tj], a[1], acc[1][tj], 0, 0, 0); }
        }
        bf16_t* o = KVR + ((size_t)(bh * 33 + c)) * 32768;
#pragma unroll
        for (int ti = 0; ti < 2; ++ti)
#pragma unroll
            for (int tj = 0; tj < 8; ++tj) *(u32x2*)(o + (size_t)(32 * wid + 16 * ti + l15) * 128 + 16 * tj + 4 * g) = pack4(acc[ti][tj]);
    }
}
__device__ __forceinline__ void cumsum_phase(const KP kp_, LAS unsigned char* lds, int vcu, int G, int wid, int lane) {
    const Params p = ldp(kp_);
    const float* LF = (const float*)(p.ws + WS_LOGF);
    LAS float* tot = (LAS float*)lds;
#pragma unroll 1
    for (int sq = vcu; sq < 64; sq += G) {
        const float* base = LF + (size_t)sq * PP; const float* base0 = LF + (size_t)(sq & 15) * PP; float* outp = (float*)(p.ws + WS_C2) + (size_t)sq * PP;
        const int cs = (wid * 66) >> 3, ce = ((wid + 1) * 66) >> 3;
        float inc[9]; float carry = 0.f;
#pragma unroll
        for (int k = 0; k < 9; ++k) { const int i = cs + k; float v = 0.f;
            if (i < ce) v = (i < 2) ? base0[64 * i + lane] : base[64 * i + lane];
            inc[k] = v; }
#pragma unroll
        for (int k = 0; k < 9; ++k) { float x = inc[k];
#pragma unroll
            for (int o = 1; o < 64; o <<= 1) { const float t = __shfl_up(x, o); if (lane >= o) x += t; }
            inc[k] = carry + x; carry += __shfl(x, 63); }
        if (lane == 0) tot[wid] = carry;
        __syncthreads();
        float pre = 0.f;
#pragma unroll
        for (int w = 0; w < 8; ++w) { const float t = tot[w]; if (w < wid) pre += t; }
#pragma unroll
        for (int k = 0; k < 9; ++k) { const int i = cs + k; if (i < ce) { const int pidx = 64 * i + lane; outp[pidx] = (pidx < 112) ? INFINITY : pre + inc[k]; } }
        __syncthreads();
    }
}
template <bool DRY> __device__ __forceinline__ void ret_scan_phase(const KP kp_, int G, int tid) {
    const Params p = ldp(kp_);
    bf16_t* KVR = (bf16_t*)(p.ws + WS_KVR);
#pragma unroll 1
    for (int it = blockIdx.x * 512 + tid; it < 131072; it += G * 512) {
        const int bh = it >> 13, off = (it & 8191) * 4, hd = bh & 3;
        const float Gm = exp2f(128.0f * lg2gamma(hd));
        u32x2* base = (u32x2*)(KVR + (size_t)bh * 33 * 32768 + off);
        u32x2 v[33];
#pragma unroll
        for (int c = 0; c < 32; ++c) v[c] = base[(size_t)c * 8192];
        v[32] = (u32x2){0u, 0u};
        f32x4 R = (f32x4){0.f, 0.f, 0.f, 0.f};
#pragma unroll
        for (int c = 0; c < 33; ++c) { const u32x2 rw = pack4(R); if (!DRY || rw.x == 0x12345679u) base[(size_t)c * 8192] = rw;
            R[0] = R[0] * Gm + bf_lo(v[c].x); R[1] = R[1] * Gm + bf_hi(v[c].x); R[2] = R[2] * Gm + bf_lo(v[c].y); R[3] = R[3] * Gm + bf_hi(v[c].y); }
    }
}
template <bool DRY> __device__ __forceinline__ void ret_out_phase(const KP kp_, LAS unsigned char* lds, int vcu, int G, int tid, int wid, int lane) {
    const Params p = ldp(kp_);
    const bf16_t* RQ = (const bf16_t*)(p.ws + WS_RQ); const bf16_t* RK = (const bf16_t*)(p.ws + WS_RK); const bf16_t* VT = (const bf16_t*)(p.ws + WS_VT);
    const bf16_t* KVR = (const bf16_t*)(p.ws + WS_KVR); bf16_t* YB = (bf16_t*)(p.ws + WS_SRG);
    const int l15 = lane & 15, g = lane >> 4;
    constexpr int PITCH = 272, VOFF = 256 * PITCH;
#pragma unroll 1
    for (int u = vcu; u < 512; u += G) {
        const int bh = u >> 5, c = (u & 31) + 1, b = bh >> 2, hd = bh & 3; const float lg = lg2gamma(hd);
        const int nl = 16 * wid + l15;
        const size_t rowq = (size_t)b * PP + 128 * c + nl;
        { const u32x4* rsrc = (const u32x4*)(KVR + ((size_t)(bh * 33 + c)) * 32768);
          u32x4 rr[8], vv[8];
#pragma unroll
          for (int i = 0; i < 8; ++i) { const int q = tid + 512 * i; rr[i] = rsrc[q];
              vv[i] = *(const u32x4*)(VT + ((size_t)(bh * 256 + (q >> 4))) * PP + 128 * c + (q & 15) * 8); }
#pragma unroll
          for (int i = 0; i < 8; ++i) { const int q = tid + 512 * i; const int off = (q >> 4) * PITCH + (q & 15) * 16;
              *(LAS u32x4*)(lds + off) = rr[i]; *(LAS u32x4*)(lds + VOFF + off) = vv[i]; } }
        bf16x8 qf[4];
#pragma unroll
        for (int s = 0; s < 4; ++s) qf[s] = *(const bf16x8*)(RQ + rowq * 512 + hd * 128 + 32 * s + 8 * g);
        __syncthreads();
        f32x4 acc[16];
#pragma unroll
        for (int ti = 0; ti < 16; ++ti) acc[ti] = (f32x4){0.f, 0.f, 0.f, 0.f};
        const LAS unsigned char* rbase = lds + l15 * PITCH + 16 * g;
#pragma unroll
        for (int s = 0; s < 4; ++s)
#pragma unroll
            for (int ti = 0; ti < 16; ++ti) { const bf16x8 a = *(const LAS bf16x8*)(rbase + 16 * ti * PITCH + 64 * s);
                acc[ti] = __builtin_amdgcn_mfma_f32_16x16x32_bf16(a, qf[s], acc[ti], 0, 0, 0); }
        const float xi = exp2f(lg * (float)(nl + 1));
#pragma unroll
        for (int ti = 0; ti < 16; ++ti) acc[ti] = acc[ti] * xi;
        const int nmb = (wid >> 1) + 1;
        const bf16_t* kp = RK + ((size_t)b * PP + 128 * c + l15) * 512 + hd * 128 + 8 * g;
        bf16x8 k0[4], k1[4], kn0[4], kn1[4];
#pragma unroll
        for (int s = 0; s < 4; ++s) { k0[s] = *(const bf16x8*)(kp + 32 * s); k1[s] = *(const bf16x8*)(kp + 16 * 512 + 32 * s); }
#pragma unroll 1
        for (int mb = 0; mb < nmb; ++mb) {
            f32x4 t0 = (f32x4){0.f, 0.f, 0.f, 0.f}, t1 = t0;
            { const bf16_t* kq = kp + (size_t)(mb + 1 < nmb ? mb + 1 : mb) * 32 * 512;
#pragma unroll
              for (int s = 0; s < 4; ++s) { kn0[s] = *(const bf16x8*)(kq + 32 * s); kn1[s] = *(const bf16x8*)(kq + 16 * 512 + 32 * s); } }
#pragma unroll
            for (int s = 0; s < 4; ++s) { t0 = __builtin_amdgcn_mfma_f32_16x16x32_bf16(k0[s], qf[s], t0, 0, 0, 0); t1 = __builtin_amdgcn_mfma_f32_16x16x32_bf16(k1[s], qf[s], t1, 0, 0, 0); }
#pragma unroll
            for (int s = 0; s < 4; ++s) { k0[s] = kn0[s]; k1[s] = kn1[s]; }
#pragma unroll
            for (int r = 0; r < 4; ++r) { const int d0 = nl - (32 * mb + 4 * g + r), d1 = d0 - 16;
                t0[r] = (d0 >= 0) ? t0[r] * exp2f(lg * (float)d0) : 0.f; t1[r] = (d1 >= 0) ? t1[r] * exp2f(lg * (float)d1) : 0.f; }
            const u32x2 s0 = pack4(t0), s1 = pack4(t1);
            const bf16x8 sb = __builtin_bit_cast(bf16x8, ((u32x4){s0.x, s0.y, s1.x, s1.y}));
            const LAS unsigned char* vbase = lds + VOFF + l15 * PITCH + 64 * mb + 8 * g;
#pragma unroll
            for (int ti = 0; ti < 16; ++ti) { const u32x2 lo = *(const LAS u32x2*)(vbase + 16 * ti * PITCH), hi2 = *(const LAS u32x2*)(vbase + 16 * ti * PITCH + 32);
                const bf16x8 a = __builtin_bit_cast(bf16x8, ((u32x4){lo.x, lo.y, hi2.x, hi2.y}));
                acc[ti] = __builtin_amdgcn_mfma_f32_16x16x32_bf16(a, sb, acc[ti], 0, 0, 0); }
        }
        float s = 0.f;
#pragma unroll
        for (int ti = 0; ti < 16; ++ti) s += (acc[ti][0] + acc[ti][1]) + (acc[ti][2] + acc[ti][3]);
        s += __shfl_xor(s, 16); s += __shfl_xor(s, 32);
        const float mean = s * (1.0f / 256.0f); float q = 0.f;
#pragma unroll
        for (int ti = 0; ti < 16; ++ti) { const f32x4 d = acc[ti] - mean; q += (d[0] * d[0] + d[1] * d[1]) + (d[2] * d[2] + d[3] * d[3]); }
        q += __shfl_xor(q, 16); q += __shfl_xor(q, 32);
        const float rstd = rsqrtf(q * (1.0f / 256.0f) + 1e-5f);
#pragma unroll
        for (int ti = 0; ti < 16; ++ti) { const int e0 = 16 * ti + 4 * g;
            const f32x4 gn = *(const f32x4*)(p.rgn + hd * 256 + e0);
            bf16_t* yp = YB + rowq * DM + hd * 256 + e0; const u32x2 sg = *(const u32x2*)yp;
            f32x4 o = (acc[ti] - mean) * rstd * gn; o[0] *= bf_lo(sg.x); o[1] *= bf_hi(sg.x); o[2] *= bf_lo(sg.y); o[3] *= bf_hi(sg.y);
            const u32x2 ow = pack4(o); if (!DRY || ow.x == 0x12345679u) *(u32x2*)yp = ow; }
        __syncthreads();
    }
}

#define XB_TMO      128
#define XB_XCNT(j)  (256  + 64 * (j))
#define XB_XSUB(j)  (1280 + 64 * (j))
#define XB_XGEN(j)  (2304 + 64 * (j))
#define XB_TOP      3328
#define XB_TOPGEN   3392
#define XCD_BAR_WORDS 3456
#define XB_SPIN_CAP (1u << 20)
constexpr size_t WS_BAR = 65536;
constexpr int LDS_MISC = 140000;
__device__ __forceinline__ unsigned xb_ld(unsigned* p)              { return __hip_atomic_load(p, __ATOMIC_RELAXED, __HIP_MEMORY_SCOPE_AGENT); }
__device__ __forceinline__ unsigned xb_add(unsigned* p, unsigned v) { return __hip_atomic_fetch_add(p, v, __ATOMIC_RELAXED, __HIP_MEMORY_SCOPE_AGENT); }
__device__ __forceinline__ unsigned xb_xcc_id() { return (unsigned)__builtin_amdgcn_s_getreg((3 << 11) | 20) & 0xFu; }
#define XB_SPIN(cond, bar) do { unsigned _sp = 0; while (cond) { __builtin_amdgcn_s_sleep(1); \
    if ((++_sp & 255u) == 0u) { if (xb_ld(&(bar)[XB_TMO])) break; if (_sp > XB_SPIN_CAP) { atomicAdd(&(bar)[XB_TMO], 1u); break; } } } } while (0)
__device__ __forceinline__ void xcd_barrier_complete(unsigned* bar, unsigned x, unsigned& nloc, unsigned& nx) {
    const unsigned G = gridDim.x * gridDim.y * gridDim.z;
    unsigned sum, cnt, mine, sp = 0u;
    for (;;) {
        sum = 0u; cnt = 0u; mine = 0u;
#pragma unroll
        for (unsigned j = 0; j < 16; ++j) { const unsigned c = xb_ld(&bar[XB_XCNT(j)]); sum += c; cnt += (c > 0u) ? 1u : 0u; mine = (j == x) ? c : mine; }
        if (sum == G) break;
        __builtin_amdgcn_s_sleep(1);
        if ((++sp & 255u) == 0u) { if (xb_ld(&bar[XB_TMO])) break; if (sp > XB_SPIN_CAP) { atomicAdd(&bar[XB_TMO], 1u); break; } }
    }
    nloc = mine > 0u ? mine : 1u; nx = cnt > 0u ? cnt : 1u;
}
__device__ __forceinline__ void xcd_barrier(unsigned* bar, volatile LAS unsigned* st) {
    asm volatile("s_waitcnt vmcnt(0)" ::: "memory");
    __syncthreads();
    if (threadIdx.x == 0) {
        const unsigned x = xb_xcc_id();
        __builtin_amdgcn_s_waitcnt(0);
        unsigned nloc = st[0], nx = st[1];
        if (nloc == 0u) { xcd_barrier_complete(bar, x, nloc, nx); st[0] = nloc; st[1] = nx; }
        const unsigned old = xb_add(&bar[XB_XSUB(x)], 1u);
        const unsigned gen = old / nloc;
        if (old + 1u == (gen + 1u) * nloc) {
            __builtin_amdgcn_fence(__ATOMIC_RELEASE, "agent");
            asm volatile("s_waitcnt vmcnt(0)" ::: "memory");
            const unsigned og = xb_add(&bar[XB_TOP], 1u);
            const unsigned tg = og / nx;
            if (og + 1u == (tg + 1u) * nx) xb_add(&bar[XB_TOPGEN], 1u);
            else XB_SPIN(xb_ld(&bar[XB_TOPGEN]) == tg, bar);
            __builtin_amdgcn_fence(__ATOMIC_ACQUIRE, "agent");
            xb_add(&bar[XB_XGEN(x)], 1u);
            asm volatile("s_waitcnt vmcnt(0)" ::: "memory");
        } else {
            XB_SPIN(xb_ld(&bar[XB_XGEN(x)]) == gen, bar);
            __builtin_amdgcn_fence(__ATOMIC_ACQUIRE, "agent");
            asm volatile("s_waitcnt vmcnt(0)" ::: "memory");
        }
    }
    __syncthreads();
}

extern __shared__ __attribute__((aligned(16))) unsigned char lds_raw[];
template <bool DRY> __device__ __forceinline__ void run_phase(const int ph) {
        const KP kp = kparams();
        int tid = threadIdx.x; asm volatile("" : "+v"(tid));
        int G = gridDim.x, bx = blockIdx.x; asm volatile("" : "+s"(G), "+s"(bx));
        LAS unsigned char* lds = (LAS unsigned char*)lds_raw;
        const int lane = tid & 63, wid = __builtin_amdgcn_readfirstlane(tid >> 6);
        const int vcu = (G % 8 == 0) ? (bx % 8) * (G / 8) + bx / 8 : bx;
        int gp = -1;
        switch (ph) {
            case 1: gp = pg8::GP_G1; break;
            case 2: gp = pg8::GP_G2; break;
            case 3: gp = pg8::GP_G3R; break;
            case 7: gp = pg8::GP_G3F; break;
            case 9: gp = pg8::GP_MIX; break;
            case 10: gp = pg8::GP_OUT; break;
            case 11: gp = pg8::GP_F2A; break;
            case 12: gp = pg8::GP_F2B; break;
            default: break;
        }
        if (gp >= 0) {
#ifndef NO_GEMM
            pg8::Epi E;
            pg8::Sched S; S.init(gp, G, bx);
            pg8::gemm_phase(lds, S, E);
            if (gp == pg8::GP_G2 && !DRY) thin_g2(kp, lds, bx, wid, lane);
            if (G == 256 && !DRY) {
                if (gp == pg8::GP_G1 && bx >= 172) { const Params p = ldp(kp); convert_range(p, (LAS float*)(lds + wid * 16384), 2, 10, (bx - 172) * 8 + wid, 84 * 8, lane); }
                if (gp == pg8::GP_G3R && bx >= 79) { const Params p = ldp(kp); convert_range(p, (LAS float*)(lds + wid * 16384), 11, 18, (bx - 79) * 8 + wid, 177 * 8, lane); }
            } else if (!DRY) {
                const Params p = ldp(kp);
                if (gp == pg8::GP_G1) convert_range(p, (LAS float*)(lds + wid * 16384), 2, 10, vcu * 8 + wid, G * 8, lane);
                if (gp == pg8::GP_G3R) convert_range(p, (LAS float*)(lds + wid * 16384), 11, 18, vcu * 8 + wid, G * 8, lane);
            }
#endif
        } else if (ph == 0) {
#ifndef NO_P0
            p0_prologue(kp, lds, vcu, G, tid, wid, lane);
#endif
        } else if (ph == 4) {
#ifndef NO_R1
            if (!DRY) cumsum_phase(kp, lds, vcu, G, wid, lane);
            ret_kv_phase(kp, vcu, G, wid, lane);
#endif
        } else if (ph == 5) {
#ifndef NO_R2
            ret_scan_phase<DRY>(kp, G, tid);
#endif
        } else if (ph == 6) {
#ifndef NO_R3
            ret_out_phase<DRY>(kp, lds, vcu, G, tid, wid, lane);
#endif
        } else if (ph == 8) {
#ifndef NO_ATTN
            unsigned char* ws = kp->ws;
            const attn_body::bf16* Qp = (const attn_body::bf16*)(ws + WS_Q); const attn_body::bf16* Kp = (const attn_body::bf16*)(ws + WS_K); const attn_body::bf16* Vp = (const attn_body::bf16*)(ws + WS_V);
            const float* C2 = (const float*)(ws + WS_C2);
            const int nun = (G == 256) ? 4 : (1024 - vcu + G - 1) / G;
#pragma unroll 1
            for (int i = 0; i < nun; ++i) {
                int bh, qb;
                if (G == 256) { const int s = vcu & 3; bh = vcu >> 2; qb = (i == 0) ? s : (i == 1) ? 7 - s : (i == 2) ? 8 + s : 15 - s; }
                else { const int idx = vcu + i * G; bh = idx >> 4; qb = idx & 15; }
                attn_body::attn_unit<32, DRY>(bh >> 4, bh & 15, qb, Qp, Kp, Vp, (const attn_body::bf16*)(ws + WS_KLEAD), (const attn_body::bf16*)(ws + WS_VLEAD), (attn_body::bf16*)(ws + WS_Q), C2, (char*)lds_raw);
            }
#endif
        }
}
#ifndef MULTI
#ifndef PROBE_PH
#define PROBE_PH -1
#endif
__global__ void __launch_bounds__(512, 2) fwd_megakernel(Params p_unused) {
    cg::grid_group grid = cg::this_grid();
    { volatile LAS unsigned* st = (volatile LAS unsigned*)((LAS unsigned char*)lds_raw + LDS_MISC);
      if (threadIdx.x == 0) { st[0] = 0u; st[1] = 0u; (void)xb_add((unsigned*)(kparams()->ws + WS_BAR) + XB_XCNT(xb_xcc_id()), 1u); }
      __syncthreads(); }
    if (gridDim.x > 65536u) grid.sync();
#pragma unroll 1
    for (int ph = 0; ph <= LAST_PHASE; ++ph) {
        if (PROBE_PH >= 0 && ph == PROBE_PH) { run_phase<true>(ph); xcd_barrier((unsigned*)(kparams()->ws + WS_BAR), (volatile LAS unsigned*)((LAS unsigned char*)lds_raw + LDS_MISC)); }
        run_phase<false>(ph);
        if (ph < 12) xcd_barrier((unsigned*)(kparams()->ws + WS_BAR), (volatile LAS unsigned*)((LAS unsigned char*)lds_raw + LDS_MISC));
    }
}
#else
template <int PH> __global__ void __launch_bounds__(512, 2) phase_kernel(Params p_unused) { run_phase<false>(PH); }
__global__ void __launch_bounds__(512, 2) gemm_kernel(Params p_unused, int ph) { run_phase<false>(ph == 1 ? 1 : ph == 2 ? 2 : ph == 3 ? 3 : ph == 7 ? 7 : ph == 9 ? 9 : ph == 10 ? 10 : ph == 11 ? 11 : 12); }
#endif

extern "C" void kernel_launch(void* const* d_in, const int* in_sizes, int n_in, void* d_out, int out_size, void* d_ws, size_t ws_size, hipStream_t stream) {
    static int grid = 0;
    if (grid == 0) {
        int dev = 0, cus = 0, per_cu = 0;
        if (hipGetDevice(&dev) != hipSuccess || hipDeviceGetAttribute(&cus, hipDeviceAttributeMultiprocessorCount, dev) != hipSuccess) { fprintf(stderr, "kernel_launch: device query failed\n"); grid = -1; return; }
#ifndef MULTI
        if (hipFuncSetAttribute((const void*)fwd_megakernel, hipFuncAttributeMaxDynamicSharedMemorySize, LDS_BYTES) != hipSuccess) { fprintf(stderr, "kernel_launch: hipFuncSetAttribute failed\n"); grid = -1; return; }
        if (hipOccupancyMaxActiveBlocksPerMultiprocessor(&per_cu, (const void*)fwd_megakernel, 512, LDS_BYTES) != hipSuccess || per_cu < 1) { fprintf(stderr, "kernel_launch: occupancy query says %d\n", per_cu); per_cu = 1; }
#else
        hipFuncSetAttribute((const void*)phase_kernel<0>, hipFuncAttributeMaxDynamicSharedMemorySize, LDS_BYTES);
        hipFuncSetAttribute((const void*)phase_kernel<4>, hipFuncAttributeMaxDynamicSharedMemorySize, LDS_BYTES);
        hipFuncSetAttribute((const void*)phase_kernel<5>, hipFuncAttributeMaxDynamicSharedMemorySize, LDS_BYTES);
        hipFuncSetAttribute((const void*)phase_kernel<6>, hipFuncAttributeMaxDynamicSharedMemorySize, LDS_BYTES);
        hipFuncSetAttribute((const void*)phase_kernel<8>, hipFuncAttributeMaxDynamicSharedMemorySize, LDS_BYTES);
        hipFuncSetAttribute((const void*)gemm_kernel, hipFuncAttributeMaxDynamicSharedMemorySize, LDS_BYTES);
#endif
        (void)hipGetLastError();
        grid = cus;
    }
    if (grid < 0) return;
    Params p{};
    p.x = (const float*)d_in[0]; p.meta = (const float*)d_in[1]; p.n1 = (const float*)d_in[2]; p.w1i = (const float*)d_in[3]; p.w1o = (const float*)d_in[4];
    p.nm = (const float*)d_in[5]; p.win = (const float*)d_in[6]; p.bfg = (const float*)d_in[7]; p.bgate = (const float*)d_in[8]; p.qn = (const float*)d_in[9];
    p.kn = (const float*)d_in[10]; p.wof = (const float*)d_in[11]; p.rgn = (const float*)d_in[12]; p.wor = (const float*)d_in[13]; p.wout = (const float*)d_in[14];
    p.n2 = (const float*)d_in[15]; p.w2i = (const float*)d_in[16]; p.w2o = (const float*)d_in[17];
    p.out = (float*)d_out; p.ws = (unsigned char*)d_ws;
#ifndef MULTI
    if (hipMemsetAsync((char*)d_ws + WS_BAR, 0, XCD_BAR_WORDS * 4, stream) != hipSuccess) { fprintf(stderr, "kernel_launch: memset failed\n"); return; }
    void* args[] = {&p};
    hipError_t e = hipLaunchCooperativeKernel((const void*)fwd_megakernel, dim3(grid), dim3(512), args, LDS_BYTES, stream);
    if (e != hipSuccess) fprintf(stderr, "cooperative launch failed: %s (grid %d)\n", hipGetErrorString(e), grid);
#else
    for (int ph = 0; ph <= LAST_PHASE; ++ph) {
        switch (ph) {
            case 0: hipLaunchKernelGGL(phase_kernel<0>, dim3(grid), dim3(512), LDS_BYTES, stream, p); break;
            case 4: hipLaunchKernelGGL(phase_kernel<4>, dim3(grid), dim3(512), LDS_BYTES, stream, p); break;
            case 5: hipLaunchKernelGGL(phase_kernel<5>, dim3(grid), dim3(512), LDS_BYTES, stream, p); break;
            case 6: hipLaunchKernelGGL(phase_kernel<6>, dim3(grid), dim3(512), LDS_BYTES, stream, p); break;
            case 8: hipLaunchKernelGGL(phase_kernel<8>, dim3(grid), dim3(512), LDS_BYTES, stream, p); break;
            default: hipLaunchKernelGGL(gemm_kernel, dim3(grid), dim3(512), LDS_BYTES, stream, p, ph); break;
        }
    }
#endif
}
```

```cpp
#include <hip/hip_runtime.h>
#include <hip/hip_cooperative_groups.h>
#include <hip/hip_bf16.h>
#include <cstdio>
#include <cstdint>
#include <cmath>
namespace cg = cooperative_groups;

#ifndef LAST_PHASE
#define LAST_PHASE 12
#endif

#define LAS __attribute__((address_space(3)))
typedef unsigned short bf16_t;
typedef short bf16x8 __attribute__((ext_vector_type(8)));
typedef float f32x4 __attribute__((ext_vector_type(4)));
typedef float f32x16 __attribute__((ext_vector_type(16)));
typedef unsigned u32x4 __attribute__((ext_vector_type(4)));
typedef unsigned u32x2 __attribute__((ext_vector_type(2)));
typedef short s16x4 __attribute__((ext_vector_type(4)));

constexpr int DM = 1024, NB = 4, SEQ = 4096, PP = 4224, MP = NB * PP  , DFF = 2816, NINC = 8208;
constexpr int NMP = MP / 256  , NMR = 64;
constexpr float LOG2E = 1.4426950408889634f;
constexpr float QC2 = 0.125f * LOG2E;

constexpr size_t MiB = 1u << 20;
constexpr size_t WS_SSQ1 = 1 * MiB, WS_SSQ2 = 2 * MiB + 256 * 1024, WS_SSQ0 = 3 * MiB + 512 * 1024, WS_LOGF = 4 * MiB + 768 * 1024;
constexpr size_t WS_COS = 6 * MiB, WS_SIN = 7 * MiB + 256 * 1024;
constexpr size_t WS_W1A = 9 * MiB, WS_W1B = 20 * MiB, WS_WIN = 25 * MiB + 512 * 1024, WS_WOF = 42 * MiB, WS_WOR = 44 * MiB, WS_WOUT = 46 * MiB;
constexpr size_t WS_W2A = 48 * MiB, WS_W2B = 59 * MiB;
constexpr size_t WS_XB = 65 * MiB;
constexpr size_t WS_BIG = 98 * MiB;
constexpr size_t WS_HID = WS_BIG;
constexpr size_t WS_RQ = WS_BIG, WS_RK = WS_BIG + 16 * MiB + 512 * 1024, WS_KT = WS_BIG + 33 * MiB, WS_VT = WS_BIG + 49 * MiB + 512 * 1024;
constexpr size_t WS_SRG = WS_BIG + 82 * MiB + 512 * 1024, WS_KVR = WS_BIG + 115 * MiB + 512 * 1024;
constexpr size_t WS_Q = WS_BIG, WS_K = WS_BIG + 33 * MiB, WS_V = WS_KVR;
constexpr size_t WS_T1 = WS_K, WS_GB = WS_V;
constexpr size_t WS_KLEAD = 128 * 1024, WS_VLEAD = 384 * 1024;
constexpr size_t WS_C2 = 9 * MiB;
static_assert(WS_KVR + 33 * MiB + 512 * 1024 <= 256 * MiB, "ws map");
constexpr int WIN_RET = 0, WIN_FOX = 3328, WIN_GA = 6400, WIN_GB = 7424, WIN_ROWS = 8448;

struct Params {
    const float* x; const float* meta; const float* n1; const float* w1i; const float* w1o; const float* nm; const float* win;
    const float* bfg; const float* bgate; const float* qn; const float* kn; const float* wof; const float* rgn; const float* wor;
    const float* wout; const float* n2; const float* w2i; const float* w2o;
    float* out; unsigned char* ws;
};

typedef const __attribute__((address_space(4))) Params* KP;
__device__ __forceinline__ Params ldp(KP kp) { Params p; p.x = kp->x; p.meta = kp->meta; p.n1 = kp->n1; p.w1i = kp->w1i; p.w1o = kp->w1o; p.nm = kp->nm; p.win = kp->win; p.bfg = kp->bfg; p.bgate = kp->bgate; p.qn = kp->qn; p.kn = kp->kn; p.wof = kp->wof; p.rgn = kp->rgn; p.wor = kp->wor; p.wout = kp->wout; p.n2 = kp->n2; p.w2i = kp->w2i; p.w2o = kp->w2o; p.out = kp->out; p.ws = kp->ws; return p; }
__device__ __forceinline__ KP kparams() { KP kp = (KP)__builtin_amdgcn_kernarg_segment_ptr(); asm volatile("" : "+s"(kp)); return kp; }
typedef float f32x2c __attribute__((ext_vector_type(2))); typedef __bf16 bf16x2c __attribute__((ext_vector_type(2)));
__device__ __forceinline__ unsigned cvt_pk_bf16(float lo, float hi) { const f32x2c v = {lo, hi}; const bf16x2c b = __builtin_convertvector(v, bf16x2c); return __builtin_bit_cast(unsigned, b); }
__device__ __forceinline__ float bf_lo(unsigned w) { return __uint_as_float(w << 16); }
__device__ __forceinline__ float bf_hi(unsigned w) { return __uint_as_float(w & 0xffff0000u); }
__device__ __forceinline__ float silu_f(float v) { return v * __builtin_amdgcn_rcpf(1.0f + __builtin_amdgcn_exp2f(-v * LOG2E)); }
__device__ __forceinline__ float sigm_f(float v) { return __builtin_amdgcn_rcpf(1.0f + __builtin_amdgcn_exp2f(-v * LOG2E)); }
__device__ __forceinline__ u32x4 pack8(f32x4 a, f32x4 b) { u32x4 w; w.x = cvt_pk_bf16(a[0], a[1]); w.y = cvt_pk_bf16(a[2], a[3]); w.z = cvt_pk_bf16(b[0], b[1]); w.w = cvt_pk_bf16(b[2], b[3]); return w; }
__device__ __forceinline__ u32x2 pack4(f32x4 a) { u32x2 w; w.x = cvt_pk_bf16(a[0], a[1]); w.y = cvt_pk_bf16(a[2], a[3]); return w; }
__device__ __forceinline__ float row_rstd(const float* ssq, int row, int fq) {
    const f32x4 v = *(const f32x4*)(ssq + (size_t)row * 16 + 4 * fq);
    float s = (v[0] + v[1]) + (v[2] + v[3]);
    s += __shfl_xor(s, 16); s += __shfl_xor(s, 32);
    return rsqrtf(s * (1.0f / 1024.0f) + 1e-6f);
}
__device__ __forceinline__ float wave_sum(float v) {
#pragma unroll
    for (int o = 1; o < 64; o <<= 1) v += __shfl_xor(v, o);
    return v;
}
#define LDS_WAIT() asm volatile("s_waitcnt lgkmcnt(0)" ::: "memory")

namespace pg8 {
constexpr int BM = 256, BK = 64, HALF = 128, HTB = HALF * BK * 2, NXCD = 8, WGM = 4;
__device__ __forceinline__ int lds_byte(int r, int c) { const int st = (r >> 4) * 2 + (c >> 5), rr = r & 15, cc = c & 31, ob = rr * 64 + cc * 2; return st * 1024 + (ob ^ (((ob >> 9) & 1) << 5)); }
__device__ __forceinline__ void stage_rc(int b, int& R, int& C) { const int st = b / 1024, sb = b % 1024, swz = sb ^ (((sb >> 9) & 1) << 5); R = (st >> 1) * 16 + swz / 64; C = (st & 1) * 32 + (swz % 64) / 2; }
__device__ __forceinline__ int perm32(int rho) { const int n = rho >> 4, i = rho & 15; return 8 * (i >> 2) + 4 * n + (i & 3); }

struct Unit { const char* a; const char* b; unsigned meta; };

enum Kind { K_SWIGLU = 0, K_RES1, K_RES2, K_FINAL, K_RQ, K_RK, K_RV, K_RG, K_FF, K_FQ, K_FK, K_FV, K_GA, K_MIXA, K_GB, K_MIXB };
enum GPhase { GP_G1 = 0, GP_G2, GP_G3R, GP_G3F, GP_MIX, GP_OUT, GP_F2A, GP_F2B };

struct Sched {
    int gp, G, c;
    __device__ __forceinline__ void init(int gp_, int G_, int c_) { gp = gp_; G = G_; c = c_; }
    __device__ __forceinline__ int kdim() const { return (gp == GP_G2 || gp == GP_F2B) ? DFF : 1024; }
    __device__ __forceinline__ bool next(int i, Unit& u) const {
        int nN, nM = NMR, real = 1, chain = 1;
        switch (gp) {
            case GP_G1: nN = 22; nM = NMP; real = 0; break;
            case GP_G2: nN = 4; break;
            case GP_G3R: nN = 13; break;
            case GP_G3F: nN = 12; break;
            case GP_MIX: nN = 4; chain = 4; break;
            case GP_OUT: nN = 4; break;
            case GP_F2A: nN = 22; break;
            default: nN = 4; break;
        }
        const int K = kdim(), nwg = nM * nN;
        const int ti = (chain == 4) ? (i >> 2) : i, sub = (chain == 4) ? (i & 3) : 0;
        const long L = (long)ti * G + c;
        if (gp == GP_G3R && L >= nwg) {
            const int j = (int)(L - nwg); if (j >= 15) return false;
            int kind, aux, brow;
            if (j < 2) { kind = K_RK; aux = j; brow = WIN_RET + (2 + j) * 256; } else if (j < 6) { kind = K_RV; aux = j - 2; brow = WIN_RET + (2 + j) * 256; }
            else if (j == 6) { kind = K_FF; aux = 0; brow = WIN_RET + 12 * 256; } else if (j < 11) { kind = K_FK; aux = (j - 7) | 4; brow = WIN_FOX + (j - 3) * 256; }
            else { kind = K_FV; aux = (j - 11) | 4; brow = WIN_FOX + (j - 3) * 256; }
            u.meta = ((unsigned)kind << 21) | ((unsigned)aux << 25);
            const char* ws = (const char*)kparams()->ws;
            u.a = ws + WS_XB; u.b = ws + WS_WIN + (size_t)brow * K * 2;
            return true;
        }
        if (L >= nwg) return false;
        int wgid = (int)L; { const int q = nwg / NXCD, r = nwg % NXCD, xcd = wgid % NXCD, off = wgid / NXCD; wgid = (xcd < r ? xcd * (q + 1) : r * (q + 1) + (xcd - r) * q) + off; }
        const int nig = WGM * nN, gid = wgid / nig, fm = gid * WGM, gsz = (nM - fm) < WGM ? (nM - fm) : WGM;
        const int pm = fm + ((wgid % nig) % gsz), pn = (wgid % nig) / gsz;
        const int row0 = real ? ((pm >> 4) * PP + 128 + (pm & 15) * 256) : pm * 256;
        int aux = 0;
        size_t aoff = WS_XB, boff = 0; int brow = pn * 256, kind = 0;
        switch (gp) {
            case GP_G1: boff = WS_W1A; kind = K_SWIGLU; break;
            case GP_G2: aoff = WS_HID; boff = WS_W1B; kind = K_RES1; break;
            case GP_G3R: boff = WS_WIN; brow = WIN_RET + pn * 256;
                if (pn < 2) { kind = K_RQ; aux = pn; } else if (pn < 4) { kind = K_RK; aux = pn - 2; } else if (pn < 8) { kind = K_RV; aux = pn - 4; } else if (pn < 12) { kind = K_RG; aux = pn - 8; } else kind = K_FF;
                break;
            case GP_G3F: boff = WS_WIN; brow = WIN_FOX + pn * 256;
                if (pn < 4) { kind = K_FQ; aux = pn; } else if (pn < 8) { kind = K_FK; aux = pn - 4; } else { kind = K_FV; aux = pn - 8; }
                break;
            case GP_MIX:
                if (sub == 0) { boff = WS_WIN; brow = WIN_GA + pn * 256; kind = K_GA; }
                else if (sub == 1) { aoff = WS_Q; boff = WS_WOF; kind = K_MIXA; }
                else if (sub == 2) { boff = WS_WIN; brow = WIN_GB + pn * 256; kind = K_GB; }
                else { aoff = WS_SRG; boff = WS_WOR; kind = K_MIXB; }
                break;
            case GP_OUT: aoff = WS_T1; boff = WS_WOUT; kind = K_RES2; break;
            case GP_F2A: boff = WS_W2A; kind = K_SWIGLU; aux = 1; break;
            default: aoff = WS_HID; boff = WS_W2B; kind = K_FINAL; break;
        }
        u.meta = (unsigned)row0 | ((unsigned)pn << 16) | ((unsigned)kind << 21) | ((unsigned)aux << 25);
        const char* ws = (const char*)kparams()->ws;
        u.a = ws + aoff + (size_t)row0 * K * 2;
        u.b = ws + boff + (size_t)brow * K * 2;
        return true;
    }
};

struct Epi {
    __device__ __forceinline__ void operator()(const f32x4 (&acc)[2][2][4][2], const Unit& u, int wr, int wc, int fr, int fq) const {
        asm volatile("" : "+v"(fr), "+v"(fq), "+s"(wr), "+s"(wc));
        const KP kp = kparams();
        unsigned char* ws = kp->ws;
        const int kind = (u.meta >> 21) & 15, pn = (u.meta >> 16) & 31, u_aux = (u.meta >> 25) & 7, u_row0 = u.meta & 0xffff, u_col0 = pn << 8;
        const int ub = u_row0 / PP;
        float rsv[2][4];
        if (!(kind == K_RES1 || kind == K_RES2 || kind == K_FINAL || kind == K_MIXA || kind == K_MIXB)) {
            const float* ssqp = (const float*)(ws + (kind == K_SWIGLU ? (u_aux ? WS_SSQ2 : WS_SSQ0) : WS_SSQ1));
            f32x4 sv[2][4];
#pragma unroll
            for (int ai = 0; ai < 2; ++ai)
#pragma unroll
                for (int m = 0; m < 4; ++m) sv[ai][m] = *(const f32x4*)(ssqp + (size_t)(u_row0 + ai * 128 + wr * 64 + m * 16 + fr) * 16 + 4 * fq);
#pragma unroll
            for (int ai = 0; ai < 2; ++ai)
#pragma unroll
                for (int m = 0; m < 4; ++m) { float sx = (sv[ai][m][0] + sv[ai][m][1]) + (sv[ai][m][2] + sv[ai][m][3]); sx += __shfl_xor(sx, 16); sx += __shfl_xor(sx, 32); rsv[ai][m] = rsqrtf(sx * (1.0f / 1024.0f) + 1e-6f); }
        } else {
#pragma unroll
            for (int ai = 0; ai < 2; ++ai)
#pragma unroll
                for (int m = 0; m < 4; ++m) rsv[ai][m] = 1.0f;
        }
#define FOR_ROWS _Pragma("unroll") for (int ai = 0; ai < 2; ++ai) _Pragma("unroll") for (int m = 0; m < 4; ++m)
#define ROWDEF const int row = u_row0 + ai * 128 + wr * 64 + m * 16 + fr
        if (kind == K_SWIGLU) {
            const float* ssq = (const float*)(ws + (u_aux ? WS_SSQ2 : WS_SSQ0));
            bf16_t* H = (bf16_t*)(ws + WS_HID);
            const int hc = (u_col0 >> 1) + wc * 32 + 8 * fq;
            FOR_ROWS { ROWDEF; const float rs = rsv[ai][m];
                f32x4 o[2];
#pragma unroll
                for (int n = 0; n < 2; ++n) { const f32x4 a = acc[ai][0][m][n] * rs, b = acc[ai][1][m][n] * rs;
#pragma unroll
                    for (int e = 0; e < 4; ++e) o[n][e] = silu_f(a[e]) * b[e]; }
                *(u32x4*)(H + (size_t)row * DFF + hc) = pack8(o[0], o[1]); }
        } else if (kind == K_RES1 || kind == K_RES2 || kind == K_FINAL) {
            float* ssq = (float*)(ws + (kind == K_RES1 ? WS_SSQ1 : WS_SSQ2));
            bf16_t* HB = (bf16_t*)(ws + WS_XB);
            const float sc = (kind == K_RES2) ? 1.0f : 0.5f;
            const int c0 = u_col0 + wc * 32 + 8 * fq;
#pragma unroll
            for (int aim = 0; aim < 4; ++aim) { const int ai = aim >> 1, m0 = 2 * (aim & 1);
                f32x4 bs[4][2][2]; u32x4 hb[4][2];
#pragma unroll
                for (int m = m0; m < m0 + 2; ++m) { ROWDEF; const int b = ub, pidx = row - ub * PP;
                    if (false) {
                    } else {
#pragma unroll
                        for (int bj = 0; bj < 2; ++bj) { hb[m][bj] = *(const u32x4*)(HB + (size_t)row * DM + c0 + bj * 128); bs[m][bj][0] = (f32x4){0.f, 0.f, 0.f, 0.f}; bs[m][bj][1] = bs[m][bj][0]; }
                    } }
                asm volatile("" ::: "memory");
#pragma unroll
                for (int m = m0; m < m0 + 2; ++m) { ROWDEF; const int b = ub, pidx = row - ub * PP; float ss = 0.f;
                    float* op = kp->out + ((size_t)(b * SEQ + pidx - 128)) * DM + c0;
#pragma unroll
                    for (int bj = 0; bj < 2; ++bj) {
                        f32x4 b0 = bs[m][bj][0], b1 = bs[m][bj][1];
                        { const u32x4 t = hb[m][bj]; b0 = (f32x4){bf_lo(t.x), bf_hi(t.x), bf_lo(t.y), bf_hi(t.y)}; b1 = (f32x4){bf_lo(t.z), bf_hi(t.z), bf_lo(t.w), bf_hi(t.w)}; }
                        const f32x4 v0 = b0 + acc[ai][bj][m][0] * sc, v1 = b1 + acc[ai][bj][m][1] * sc;
                        if (kind == K_FINAL) { *(f32x4*)(op + bj * 128) = v0; *(f32x4*)(op + bj * 128 + 4) = v1; }
                        else { *(u32x4*)(HB + (size_t)row * DM + c0 + bj * 128) = pack8(v0, v1);
                            ss += (v0[0] * v0[0] + v0[1] * v0[1]) + (v0[2] * v0[2] + v0[3] * v0[3]) + (v1[0] * v1[0] + v1[1] * v1[1]) + (v1[2] * v1[2] + v1[3] * v1[3]); }
                    }
                    if (kind != K_FINAL) { ss += __shfl_xor(ss, 16); ss += __shfl_xor(ss, 32);
                        if (fq == 0) ssq[(size_t)row * 16 + pn * 4 + wc] = ss; } }
            }
        } else if (kind == K_RQ || kind == K_RK) {
            const float* ssq = (const float*)(ws + WS_SSQ1);
            const float* COS = (const float*)(ws + WS_COS); const float* SIN = (const float*)(ws + WS_SIN);
            const int hh = wc >> 1, i0 = 32 * (wc & 1) + 8 * fq, hd = 2 * u_aux + hh;
            bf16_t* RQ = (bf16_t*)(ws + (kind == K_RQ ? WS_RQ : WS_RK)); bf16_t* KT = (bf16_t*)(ws + WS_KT);
#pragma unroll
            for (int aim = 0; aim < 4; ++aim) { const int ai = aim >> 1, m0 = 2 * (aim & 1);
                f32x4 csv[4][2], snv[4][2];
#pragma unroll
                for (int m = m0; m < m0 + 2; ++m) { ROWDEF; const int b = ub, pidx = row - ub * PP;
#pragma unroll
                    for (int n = 0; n < 2; ++n) { csv[m][n] = *(const f32x4*)(COS + (size_t)pidx * 64 + i0 + 4 * n); snv[m][n] = *(const f32x4*)(SIN + (size_t)pidx * 64 + i0 + 4 * n); } }
#pragma unroll
                for (int m = m0; m < m0 + 2; ++m) { ROWDEF; const float rs = rsv[ai][m]; const int b = ub, pidx = row - ub * PP;
                    const float ksc = (kind == K_RK) ? (pidx >= 112 ? 0.08838834764831845f : 0.f) : 1.0f;
                    f32x4 y1v[2], y2v[2];
#pragma unroll
                    for (int n = 0; n < 2; ++n) {
                        const f32x4 cs = csv[m][n], sn = snv[m][n];
                        const f32x4 x1 = acc[ai][0][m][n] * rs, x2 = acc[ai][1][m][n] * rs;
                        y1v[n] = (x1 * cs - x2 * sn) * ksc; y2v[n] = (x2 * cs + x1 * sn) * ksc;
                        if (kind == K_RK) {
                            bf16_t* kt = KT + ((size_t)((b * 4 + hd) * 128 + i0 + 4 * n)) * PP + pidx;
#pragma unroll
                            for (int e = 0; e < 4; ++e) { kt[(size_t)e * PP] = (bf16_t)cvt_pk_bf16(y1v[n][e], 0.f); kt[(size_t)(64 + e) * PP] = (bf16_t)cvt_pk_bf16(y2v[n][e], 0.f); }
                        }
                    }
                    { bf16_t* o = RQ + (size_t)row * 512 + hd * 128 + i0;
                      *(u32x4*)o = pack8(y1v[0], y1v[1]); *(u32x4*)(o + 64) = pack8(y2v[0], y2v[1]); } }
            }
        } else if (kind == K_RV) {
            const float* ssq = (const float*)(ws + WS_SSQ1); bf16_t* VT = (bf16_t*)(ws + WS_VT); const int hd = u_aux;
            FOR_ROWS { ROWDEF; float rs = rsv[ai][m]; const int b = ub, pidx = row - ub * PP; if (pidx < 112) rs = 0.f;
#pragma unroll
                for (int bj = 0; bj < 2; ++bj)
#pragma unroll
                    for (int n = 0; n < 2; ++n) { const f32x4 v = acc[ai][bj][m][n] * rs; const int e0 = 128 * bj + 32 * wc + 8 * fq + 4 * n;
                        bf16_t* vt = VT + ((size_t)((b * 4 + hd) * 256 + e0)) * PP + pidx;
#pragma unroll
                        for (int e = 0; e < 4; ++e) vt[(size_t)e * PP] = (bf16_t)cvt_pk_bf16(v[e], 0.f); } }
        } else if (kind == K_RG || kind == K_FV) {
            const float* ssq = (const float*)(ws + WS_SSQ1); const bool lead = (u_aux & 4) != 0; bf16_t* O = (bf16_t*)(ws + (kind == K_RG ? WS_SRG : (lead ? WS_VLEAD : WS_V)));
            const int c0 = 256 * (u_aux & 3) + wc * 32 + 8 * fq;
            FOR_ROWS { ROWDEF; const float rs = rsv[ai][m];
#pragma unroll
                for (int bj = 0; bj < 2; ++bj) { f32x4 v0 = acc[ai][bj][m][0] * rs, v1 = acc[ai][bj][m][1] * rs;
                    if (kind == K_RG) {
#pragma unroll
                        for (int e = 0; e < 4; ++e) { v0[e] = silu_f(v0[e]); v1[e] = silu_f(v1[e]); } }
                    if (!lead || row < 128) *(u32x4*)(O + (size_t)row * DM + c0 + bj * 128) = pack8(v0, v1); } }
        } else if (kind == K_FF) {
            const float* ssq = (const float*)(ws + WS_SSQ1); float* LF = (float*)(ws + WS_LOGF);
            float fb[2][4];
#pragma unroll
            for (int n = 0; n < 2; ++n)
#pragma unroll
                for (int e = 0; e < 4; ++e) fb[n][e] = kp->bfg[(8 * fq + 4 * n + e) & 15];
            FOR_ROWS { ROWDEF; const float rs = rsv[ai][m]; const int b = ub, pidx = row - ub * PP;
                if (wc == 0 && fq < 2) {
#pragma unroll
                    for (int n = 0; n < 2; ++n)
#pragma unroll
                        for (int e = 0; e < 4; ++e) { const int hx = 8 * fq + 4 * n + e; const float v = acc[ai][0][m][n][e] * rs + fb[n][e];
                            const float lf = fminf(v, 0.f) * LOG2E - __builtin_amdgcn_logf(1.0f + __builtin_amdgcn_exp2f(-fabsf(v) * LOG2E));
                            LF[((size_t)(b * 16 + hx)) * PP + pidx] = (pidx >= 112) ? lf : 0.f; } } }
        } else if (kind == K_FQ || kind == K_FK) {
            const float* ssq = (const float*)(ws + WS_SSQ1); const bool lead = (u_aux & 4) != 0; bf16_t* O = (bf16_t*)(ws + (kind == K_FQ ? WS_Q : (lead ? WS_KLEAD : WS_K)));
            const float* gn = (kind == K_FQ) ? kp->qn : kp->kn; const float osc = (kind == K_FQ) ? QC2 : 1.0f;
            const int head = 4 * (u_aux & 3) + wc;
            f32x4 gq[2][2];
#pragma unroll
            for (int bj = 0; bj < 2; ++bj) { gq[bj][0] = *(const f32x4*)(gn + 32 * bj + 8 * fq); gq[bj][1] = *(const f32x4*)(gn + 32 * bj + 8 * fq + 4); }
            FOR_ROWS { ROWDEF; const float rs = rsv[ai][m];
                f32x4 v[2][2]; float ss = 0.f;
#pragma unroll
                for (int bj = 0; bj < 2; ++bj)
#pragma unroll
                    for (int n = 0; n < 2; ++n) { v[bj][n] = acc[ai][bj][m][n] * rs; const f32x4 t = v[bj][n]; ss += (t[0] * t[0] + t[1] * t[1]) + (t[2] * t[2] + t[3] * t[3]); }
                ss += __shfl_xor(ss, 16); ss += __shfl_xor(ss, 32);
                const float r2 = rsqrtf(ss * (1.0f / 64.0f) + 1e-6f) * osc;
#pragma unroll
                for (int bj = 0; bj < 2; ++bj) { const f32x4 g0 = gq[bj][0], g1 = gq[bj][1];
                    if (!lead || row < 128) *(u32x4*)(O + (size_t)row * DM + head * 64 + 32 * bj + 8 * fq) = pack8(v[bj][0] * g0 * r2, v[bj][1] * g1 * r2); } }
        } else if (kind == K_GA || kind == K_GB) {
            bf16_t* O = (bf16_t*)(ws + (kind == K_GA ? WS_T1 : WS_GB));
            const int c0 = u_col0 + wc * 32 + 8 * fq;
            f32x4 gq[2][2];
#pragma unroll
            for (int bj = 0; bj < 2; ++bj) { const float* bg = kp->bgate + (kind == K_GB ? 1024 : 0) + c0 + bj * 128; gq[bj][0] = *(const f32x4*)bg; gq[bj][1] = *(const f32x4*)(bg + 4); }
            FOR_ROWS { ROWDEF; const float rs = rsv[ai][m];
#pragma unroll
                for (int bj = 0; bj < 2; ++bj) { const int c = c0 + bj * 128; f32x4 v0 = acc[ai][bj][m][0], v1 = acc[ai][bj][m][1];
#pragma unroll
                    for (int e = 0; e < 4; ++e) { v0[e] = sigm_f(v0[e] * rs + gq[bj][0][e]); v1[e] = sigm_f(v1[e] * rs + gq[bj][1][e]); }
                    *(u32x4*)(O + (size_t)row * DM + c) = pack8(v0, v1); } }
        } else {
            bf16_t* T1 = (bf16_t*)(ws + WS_T1); bf16_t* GB = (bf16_t*)(ws + WS_GB);
            const int c0 = u_col0 + wc * 32 + 8 * fq;
#pragma unroll
            for (int aim = 0; aim < 4; ++aim) { const int ai = aim >> 1, m0 = 2 * (aim & 1);
                u32x4 tt[4][2], gg[4][2];
#pragma unroll
                for (int m = m0; m < m0 + 2; ++m) { ROWDEF;
#pragma unroll
                    for (int bj = 0; bj < 2; ++bj) { tt[m][bj] = *(const u32x4*)(T1 + (size_t)row * DM + c0 + bj * 128); gg[m][bj] = (u32x4){0u, 0u, 0u, 0u}; if (kind == K_MIXB) gg[m][bj] = *(const u32x4*)(GB + (size_t)row * DM + c0 + bj * 128); } }
#pragma unroll
                for (int m = m0; m < m0 + 2; ++m) { ROWDEF;
#pragma unroll
                    for (int bj = 0; bj < 2; ++bj) { f32x4 v0 = acc[ai][bj][m][0], v1 = acc[ai][bj][m][1]; const u32x4 t = tt[m][bj], g = gg[m][bj];
                        if (kind == K_MIXA) {
                            v0[0] *= bf_lo(t.x); v0[1] *= bf_hi(t.x); v0[2] *= bf_lo(t.y); v0[3] *= bf_hi(t.y); v1[0] *= bf_lo(t.z); v1[1] *= bf_hi(t.z); v1[2] *= bf_lo(t.w); v1[3] *= bf_hi(t.w);
                        } else {
                            v0[0] = bf_lo(t.x) + bf_lo(g.x) * v0[0]; v0[1] = bf_hi(t.x) + bf_hi(g.x) * v0[1]; v0[2] = bf_lo(t.y) + bf_lo(g.y) * v0[2]; v0[3] = bf_hi(t.y) + bf_hi(g.y) * v0[3];
                            v1[0] = bf_lo(t.z) + bf_lo(g.z) * v1[0]; v1[1] = bf_hi(t.z) + bf_hi(g.z) * v1[1]; v1[2] = bf_lo(t.w) + bf_lo(g.w) * v1[2]; v1[3] = bf_hi(t.w) + bf_hi(g.w) * v1[3];
                        }
                        *(u32x4*)(T1 + (size_t)row * DM + c0 + bj * 128) = pack8(v0, v1); } }
            }
        }
#undef FOR_ROWS
#undef ROWDEF
    }
};

__device__ __forceinline__ void gemm_phase(LAS unsigned char* lds, const Sched& S, const Epi& E) {
    int tid_ = threadIdx.x; asm volatile("" : "+v"(tid_));
    const int tid = tid_, wid = __builtin_amdgcn_readfirstlane(tid >> 6), lane = tid & 63, wr = wid >> 2, wc = wid & 3, fr = lane & 15, fq = lane >> 4;
    const int K = S.kdim(), nt = K / BK;
    unsigned voffA[2], voffB[2];
#pragma unroll
    for (int i = 0; i < 2; ++i) { int R, C; stage_rc(tid * 16 + i * 8192, R, C); const int Rb = (R & ~31) + perm32(R & 31);
        voffA[i] = (unsigned)(R * K + C) * 2u; voffB[i] = (unsigned)(Rb * K + C) * 2u; }
    const size_t kstep = (size_t)(BK * 2);
    const size_t hstep = (size_t)HALF * K * 2;
    const unsigned ldsw = (unsigned)wid * 1024u;
    const int aoff = lds_byte(wr * 64 + fr, fq * 8), boff = lds_byte(wc * 32 + fr, fq * 8);
#define PG8_SA(b, h) (((b) * 2 + (h)) * HTB)
#define PG8_SB(b, h) ((4 + (b) * 2 + (h)) * HTB)
#define PG8_STAGE(bufoff, gbase, voff) do { _Pragma("unroll") for (int _i = 0; _i < 2; ++_i) \
        __builtin_amdgcn_global_load_lds((const unsigned*)((const char*)(gbase) + (voff)[_i]), (LAS unsigned*)(lds + (bufoff) + ldsw + _i * 8192), 16, 0, 0); } while (0)
#define PG8_LDA(dst, b, h) do { _Pragma("unroll") for (int m = 0; m < 4; ++m) _Pragma("unroll") for (int k = 0; k < 2; ++k) dst[m][k] = *(const LAS bf16x8*)(lds + PG8_SA(b, h) + aoff + m * 2048 + k * 1024); } while (0)
#define PG8_LDB(dst, b, h) do { _Pragma("unroll") for (int n = 0; n < 2; ++n) _Pragma("unroll") for (int k = 0; k < 2; ++k) dst[n][k] = *(const LAS bf16x8*)(lds + PG8_SB(b, h) + boff + n * 2048 + k * 1024); } while (0)
#define PG8_MMA(ai, bj, At, Bt) do { __builtin_amdgcn_s_setprio(1); _Pragma("unroll") for (int m = 0; m < 4; ++m) _Pragma("unroll") for (int n = 0; n < 2; ++n) _Pragma("unroll") for (int k = 0; k < 2; ++k) \
        acc[ai][bj][m][n] = __builtin_amdgcn_mfma_f32_16x16x32_bf16(Bt[n][k], At[m][k], acc[ai][bj][m][n], 0, 0, 0); __builtin_amdgcn_s_setprio(0); } while (0)
#define PG8_WAIT_V(n) asm volatile("s_waitcnt vmcnt(" #n ")" ::: "memory")
#define PG8_WAIT_L(n) asm volatile("s_waitcnt lgkmcnt(" #n ")" ::: "memory")
#define PG8_BAR __builtin_amdgcn_s_barrier()
#define PG8_SCHED __builtin_amdgcn_sched_barrier(0)
    Unit cur, nxt; int ui = 0;
    if (!S.next(0, cur)) return;
    f32x4 acc[2][2][4][2];
#pragma unroll
    for (int a = 0; a < 2; ++a)
#pragma unroll
        for (int b = 0; b < 2; ++b)
#pragma unroll
            for (int m = 0; m < 4; ++m)
#pragma unroll
                for (int n = 0; n < 2; ++n) acc[a][b][m][n] = (f32x4){0.f, 0.f, 0.f, 0.f};
    bf16x8 At[4][2], B0[2][2], B1[2][2];
    const char* cA = cur.a; const char* cB = cur.b;
    PG8_STAGE(PG8_SB(0, 0), cB, voffB); PG8_STAGE(PG8_SB(0, 1), cB + hstep, voffB); PG8_STAGE(PG8_SA(0, 0), cA, voffA); PG8_STAGE(PG8_SA(0, 1), cA + hstep, voffA);
    if (wr == 1) PG8_BAR;
    PG8_WAIT_V(2); PG8_BAR;
    PG8_STAGE(PG8_SB(1, 0), cB + kstep, voffB); PG8_STAGE(PG8_SA(1, 0), cA + kstep, voffA); PG8_STAGE(PG8_SB(1, 1), cB + hstep + kstep, voffB);
    PG8_WAIT_V(6); PG8_BAR;
    for (;;) {
        const bool has_next = S.next(ui + 1, nxt);
        const char* nA = has_next ? nxt.a : cA; const char* nB = has_next ? nxt.b : cB;
        for (int t = 0; t < nt; t += 2) {
            const bool last = (t == nt - 2);
            const char* a1 = cA + (size_t)(t + 1) * kstep;
            const char* a2 = last ? nA : cA + (size_t)(t + 2) * kstep; const char* b2 = last ? nB : cB + (size_t)(t + 2) * kstep;
            const char* a3 = a2 + kstep; const char* b3 = b2 + kstep;
            PG8_LDB(B0, 0, 0); PG8_LDB(B1, 0, 1); PG8_SCHED; PG8_LDA(At, 0, 0); PG8_STAGE(PG8_SA(1, 1), a1 + hstep, voffA);
            PG8_WAIT_V(8); PG8_WAIT_L(0); PG8_BAR; PG8_MMA(0, 0, At, B0); PG8_MMA(0, 1, At, B1); PG8_BAR; PG8_SCHED;
            PG8_LDA(At, 0, 1); PG8_STAGE(PG8_SB(0, 0), b2, voffB); PG8_STAGE(PG8_SB(0, 1), b2 + hstep, voffB); PG8_STAGE(PG8_SA(0, 0), a2, voffA);
            PG8_WAIT_V(8); PG8_WAIT_L(0); PG8_BAR; PG8_MMA(1, 0, At, B0); PG8_MMA(1, 1, At, B1); PG8_BAR; PG8_SCHED;
            PG8_LDB(B0, 1, 0); PG8_LDB(B1, 1, 1); PG8_SCHED; PG8_LDA(At, 1, 0); PG8_STAGE(PG8_SA(0, 1), a2 + hstep, voffA);
            PG8_WAIT_V(8); PG8_WAIT_L(0); PG8_BAR; PG8_MMA(0, 0, At, B0); PG8_MMA(0, 1, At, B1); PG8_BAR; PG8_SCHED;
            PG8_LDA(At, 1, 1); PG8_STAGE(PG8_SB(1, 0), b3, voffB); PG8_STAGE(PG8_SB(1, 1), b3 + hstep, voffB); PG8_STAGE(PG8_SA(1, 0), a3, voffA);
            PG8_WAIT_V(8); PG8_WAIT_L(0); PG8_BAR; PG8_MMA(1, 0, At, B0); PG8_MMA(1, 1, At, B1); PG8_BAR; PG8_SCHED;
        }
        if (wr == 0) PG8_BAR;
        E(acc, cur, wr, wc, fr, fq);
        if (!has_next) break;
#pragma unroll
        for (int a = 0; a < 2; ++a)
#pragma unroll
            for (int b = 0; b < 2; ++b)
#pragma unroll
                for (int m = 0; m < 4; ++m)
#pragma unroll
                    for (int n = 0; n < 2; ++n) acc[a][b][m][n] = (f32x4){0.f, 0.f, 0.f, 0.f};
        cur = nxt; cA = nA; cB = nB; ++ui;
        if (wr == 1) PG8_BAR;
    }
    PG8_WAIT_V(0);
    PG8_BAR;
#undef PG8_SA
#undef PG8_SB
#undef PG8_STAGE
#undef PG8_LDA
#undef PG8_LDB
#undef PG8_MMA
#undef PG8_WAIT_V
#undef PG8_WAIT_L
#undef PG8_BAR
#undef PG8_SCHED
}
}

namespace attn_body {
using bf16 = __hip_bfloat16;
constexpr int D = 64, NW = 8, QBLK = 32, QB = QBLK * NW, KVBLK = 64;
__device__ __forceinline__ int crow(int r, int hi) { return (r & 3) + 8 * (r >> 2) + 4 * hi; }
#define SBAR() __builtin_amdgcn_sched_barrier(0)
__device__ __forceinline__ void cmask(f32x16& p0, f32x16& p1, int jb, int qrel, int hi) {
    const float NEG = -INFINITY; int kb = 64 * jb + 4 * hi;
#pragma unroll
    for (int r = 0; r < 16; ++r) { int kv = kb + (r & 3) + 8 * (r >> 2); if (kv > qrel) p0[r] = NEG; if (kv + 32 > qrel) p1[r] = NEG; }
}
constexpr int NSLOT = 3, SLOTB = 8192;
constexpr int LDS_K = 0, LDS_V = NSLOT * SLOTB, LDS_WS = 2 * NSLOT * SLOTB, LDS_OST = LDS_WS + NW * 64 * 4, LDS_BYTES = LDS_OST + NW * 4096;
constexpr int LDS_C2 = 86016, LDS_C2T = 103424;
__device__ __forceinline__ void glds16(const void* gsrc, unsigned lds_dst) { unsigned keep;
    asm volatile("s_mov_b32 %0, m0\n\ts_mov_b32 m0, %2\n\ts_nop 0\n\tglobal_load_lds_dwordx4 %1, off\n\ts_mov_b32 m0, %0" : "=&s"(keep) : "v"(gsrc), "s"(lds_dst) : "memory"); }
__device__ __forceinline__ float max3f(float a, float b, float c) { float r; asm("v_max3_f32 %0, %1, %2, %3" : "=v"(r) : "v"(a), "v"(b), "v"(c)); return r; }
__device__ __forceinline__ float max2f(float a, float b) { float r; asm("v_max_f32_e32 %0, %1, %2" : "=v"(r) : "v"(a), "v"(b)); return r; }
__device__ __forceinline__ float fadd_s(float a, float b) { float r; asm("v_add_f32_e32 %0, %1, %2" : "=v"(r) : "v"(a), "v"(b)); return r; }
__device__ __forceinline__ float fsub_s(float a, float b) { float r; asm("v_sub_f32_e32 %0, %1, %2" : "=v"(r) : "v"(a), "v"(b)); return r; }
typedef float f32x2_t __attribute__((ext_vector_type(2))); typedef __bf16 bf16x2_t __attribute__((ext_vector_type(2)));
__device__ __forceinline__ unsigned cvtpk_s(float lo, float hi) { f32x2_t v = {lo, hi}; bf16x2_t b = __builtin_convertvector(v, bf16x2_t); return __builtin_bit_cast(unsigned, b); }
#define WAIT_BAR(N) asm volatile("s_waitcnt vmcnt(" #N ") lgkmcnt(0)\n\ts_barrier" ::: "memory")

__device__ __forceinline__ void qkt(f32x16& p0, f32x16& p1, const char* Kslot, const bf16x8* qr, const f32x16& negm, int r32, int hi) {
    const char* kb = Kslot + hi * 1024 + r32 * 16;
#pragma unroll
    for (int d0 = 0; d0 < 4; ++d0) {
        const bf16x8 b0 = *reinterpret_cast<const bf16x8*>(kb + d0 * 2048);
        const bf16x8 b1 = *reinterpret_cast<const bf16x8*>(kb + d0 * 2048 + 512);
        if (d0 == 0) { p0 = __builtin_amdgcn_mfma_f32_32x32x16_bf16(b0, qr[0], negm, 0, 0, 0); p1 = __builtin_amdgcn_mfma_f32_32x32x16_bf16(b1, qr[0], negm, 0, 0, 0); }
        else { p0 = __builtin_amdgcn_mfma_f32_32x32x16_bf16(b0, qr[d0], p0, 0, 0, 0); p1 = __builtin_amdgcn_mfma_f32_32x32x16_bf16(b1, qr[d0], p1, 0, 0, 0); } }
}
typedef __attribute__((address_space(3))) const char* lds_cptr;
typedef short v4i16_t __attribute__((ext_vector_type(4)));
__device__ __forceinline__ void kload8(bf16x8* kf, lds_cptr kp) {
    kf[0] = *(const LAS bf16x8*)(kp);        kf[1] = *(const LAS bf16x8*)(kp + 512);
    kf[2] = *(const LAS bf16x8*)(kp + 2048); kf[3] = *(const LAS bf16x8*)(kp + 2560);
    kf[4] = *(const LAS bf16x8*)(kp + 4096); kf[5] = *(const LAS bf16x8*)(kp + 4608);
    kf[6] = *(const LAS bf16x8*)(kp + 6144); kf[7] = *(const LAS bf16x8*)(kp + 6656);
}
__device__ __forceinline__ void kload2(bf16x8* kf, lds_cptr kp, int j) { kf[2 * j] = *(const LAS bf16x8*)(kp + j * 2048); kf[2 * j + 1] = *(const LAS bf16x8*)(kp + j * 2048 + 512); }
__device__ __forceinline__ s16x4 vtr(lds_cptr p) { return __builtin_bit_cast(s16x4, __builtin_amdgcn_ds_read_tr16_b64_v4i16((LAS v4i16_t*)p)); }
__device__ __forceinline__ float rowmax(const f32x16& p0, const f32x16& p1) {
    float a = max3f(p0[0], p0[1], p1[0]), b = max3f(p0[2], p0[3], p1[1]); a = max3f(a, p1[2], p1[3]);
#pragma unroll
    for (int r = 4; r < 16; r += 4) { a = max3f(a, p0[r], p0[r + 1]); b = max3f(b, p0[r + 2], p0[r + 3]); a = max3f(a, p1[r], p1[r + 1]); b = max3f(b, p1[r + 2], p1[r + 3]); }
    const float m = max2f(a, b);
    auto rr = __builtin_amdgcn_permlane32_swap(__float_as_uint(m), __float_as_uint(m), false, false);
    return max2f(__uint_as_float(rr[0]), __uint_as_float(rr[1]));
}
__device__ __forceinline__ void pv(f32x16* o, int vb, bf16x8 pa0, bf16x8 pa1, bf16x8 pa2, bf16x8 pa3) {
#pragma unroll
    for (int d0 = 0; d0 < 2; ++d0) { s16x4 lo[4], hi[4];
#pragma unroll
        for (int ks = 0; ks < 4; ++ks) {
            asm volatile("ds_read_b64_tr_b16 %0,%1 offset:%c2" : "=&v"(lo[ks]) : "v"(vb), "i"(d0 * 4096 + ks * 1024) : "memory");
            asm volatile("ds_read_b64_tr_b16 %0,%1 offset:%c2" : "=&v"(hi[ks]) : "v"(vb), "i"(d0 * 4096 + ks * 1024 + 512) : "memory"); }
        asm volatile("s_waitcnt lgkmcnt(0)" ::: "memory"); SBAR();
#define PK(k) (bf16x8){lo[k][0], lo[k][1], lo[k][2], lo[k][3], hi[k][0], hi[k][1], hi[k][2], hi[k][3]}
        o[d0] = __builtin_amdgcn_mfma_f32_32x32x16_bf16(pa0, PK(0), o[d0], 0, 0, 0);
        o[d0] = __builtin_amdgcn_mfma_f32_32x32x16_bf16(pa1, PK(1), o[d0], 0, 0, 0);
        o[d0] = __builtin_amdgcn_mfma_f32_32x32x16_bf16(pa2, PK(2), o[d0], 0, 0, 0);
        o[d0] = __builtin_amdgcn_mfma_f32_32x32x16_bf16(pa3, PK(3), o[d0], 0, 0, 0);
#undef PK
    }
}

template <int THRL, bool DRY> __device__ __forceinline__ void attn_unit(int b, int h, int qb, const bf16* Q, const bf16* __restrict__ K, const bf16* __restrict__ V, const bf16* __restrict__ KL, const bf16* __restrict__ VL, bf16* O, const float* __restrict__ C2, char* shm) {
    int tid_ = threadIdx.x; asm volatile("" : "+v"(tid_));
    const int tid = tid_, lane = tid & 63, r32 = lane & 31, hi = lane >> 5; const int wid = __builtin_amdgcn_readfirstlane(tid >> 6);
    const long rowbase = (long)b * PP; const int q0 = 128 + qb * QB;
    const bf16* Qw = Q + (rowbase + q0 + wid * QBLK) * DM + h * D;
    const bf16* Kh = K + (rowbase + 64) * DM + h * D, *Vh = V + (rowbase + 64) * DM + h * D;
    const unsigned lds0 = (unsigned)(uintptr_t)shm;
    float* wsf = (float*)(shm + LDS_WS) + wid * 64;
    const int NT = 6 + 4 * qb, NTR = NT - 1;
    const lds_cptr shm3 = (lds_cptr)shm;
    const float* c2g = C2 + ((size_t)(b * 16 + h)) * PP + 64;
    { LAS float* c2w = (LAS float*)(shm3 + LDS_C2); LAS float* c2tw = (LAS float*)(shm3 + LDS_C2T);
      for (int i = tid; i < 64 * NT; i += 512) c2w[i] = (i < 64 * NTR) ? (c2g[i] - c2g[i | 63]) : 0.f;
      if (tid < NT) c2tw[tid] = (tid < NTR) ? c2g[64 * tid + 63] : 0.f; }
    const float c2q = c2g[q0 - 64 + wid * QBLK + r32];
    const LAS float* c2s = (const LAS float*)(shm3 + LDS_C2) + 4 * hi;
    const LAS float* c2t = (const LAS float*)(shm3 + LDS_C2T);
    const bf16* ksrc = Kh + (long)lane * DM + wid * 8;
    const bf16* vsrc = Vh + (long)(16 * (wid & 3) + (lane >> 2)) * DM + (wid >> 2) * 32 + (lane & 3) * 8;
    const unsigned kdst = lds0 + LDS_K + wid * 1024, vdst = lds0 + LDS_V + wid * 1024;
#define TCL(t) (((t) < NTR) ? (t) : (NTR - 1))
#define DMA_K(t, slot) glds16(ksrc + (long)TCL(t) * KVBLK * DM, (unsigned)__builtin_amdgcn_readfirstlane(kdst + (slot)))
#define DMA_V(t, slot) glds16(vsrc + (long)TCL(t) * KVBLK * DM, (unsigned)__builtin_amdgcn_readfirstlane(vdst + (slot)))
    const int vb0 = (int)(lds0 + LDS_V) + ((lane >> 4) & 1) * 32 + (lane & 3) * 8 + (4 * hi + ((lane & 15) >> 2)) * 64;
    const char* Kbase = shm + LDS_K; bf16x8 kf[8];
    const lds_cptr kp0 = shm3 + LDS_K + hi * 1024 + r32 * 16; const lds_cptr vp0 = shm3 + LDS_V + ((lane >> 4) & 1) * 32 + (lane & 3) * 8 + (4 * hi + ((lane & 15) >> 2)) * 64;
    glds16(KL + (long)(64 + lane) * DM + h * D + wid * 8, (unsigned)__builtin_amdgcn_readfirstlane(kdst));
    glds16(VL + (long)(64 + 16 * (wid & 3) + (lane >> 2)) * DM + h * D + (wid >> 2) * 32 + (lane & 3) * 8, (unsigned)__builtin_amdgcn_readfirstlane(vdst));
    DMA_K(1, SLOTB);
    bf16x8 qr[4];
#pragma unroll
    for (int d0 = 0; d0 < 4; ++d0) qr[d0] = *reinterpret_cast<const bf16x8*>(&Qw[(long)r32 * DM + d0 * 16 + hi * 8]);
    float l_reg = 0.f; f32x16 o[2]; o[0] = f32x16{}; o[1] = f32x16{}; const f32x16 negm = f32x16{}; float moff = 0.f, mq = 0.f;
    const int qrel = wid * QBLK + r32;
#define CMASK(P0, P1, t) do { int jb_ = (t) - (NT - 5); if (jb_ >= 0) cmask(P0, P1, jb_, qrel, hi); } while (0)
    bool resc = false;
#define EXD(P, OFF) do { _Pragma("unroll") for (int g_ = 0; g_ < 4; ++g_) { const f32x4 dk_ = *(const LAS f32x4*)(c2s + (OFF) + 8 * g_); \
      _Pragma("unroll") for (int i_ = 0; i_ < 4; ++i_) P[4 * g_ + i_] = __builtin_amdgcn_exp2f((P[4 * g_ + i_] - moff) - dk_[i_]); } } while (0)
#define START(P0, P1) do { const float rmr = rowmax(P0, P1); resc = false; \
    mq = rmr - c2t[0]; moff = rmr; \
    EXD(P0, 0); } while (0)
#define RESC() do { if (resc) { asm volatile("s_waitcnt lgkmcnt(0)" ::: "memory"); \
      _Pragma("unroll") for (int d_ = 0; d_ < 2; ++d_) _Pragma("unroll") for (int r = 0; r < 16; ++r) o[d_][r] *= wsf[crow(r, hi)]; } } while (0)
    f32x16 pA0, pA1, pB0, pB1;
    int sl_prev = 0, sl_cur = 0, sl_next = SLOTB;
#define ROT() do { sl_prev = sl_cur; sl_cur = sl_next; sl_next = (sl_next == (NSLOT - 1) * SLOTB) ? 0 : sl_next + SLOTB; } while (0)
    DMA_K(2, 2 * SLOTB);
    WAIT_BAR(3);
    qkt(pA0, pA1, Kbase, qr, negm, r32, hi); asm volatile("s_nop 15\n\ts_nop 7" : "+v"(pA0), "+v"(pA1)); CMASK(pA0, pA1, 0);
    START(pA0, pA1);
    EXD(pA1, 32);
    WAIT_BAR(0);
    DMA_K(3, 0); DMA_V(1, SLOTB);
    ROT();
    kload8(kf, kp0 + sl_cur);
    WAIT_BAR(2);
    s16x4 vlo[8], vhi[8]; u32x4 pw0, pw1, pw2, pw3;
#define PKW(P, B) cvtpk_s(P[B], P[B + 1])
#define PAF(k) __builtin_bit_cast(bf16x8, pw##k)
#define VFR(i) (bf16x8){vlo[i][0], vlo[i][1], vlo[i][2], vlo[i][3], vhi[i][0], vhi[i][1], vhi[i][2], vhi[i][3]}
#define PIN(x) asm volatile("" : "+v"(x))
#define MX3(a, b, c) __builtin_fmaxf(__builtin_fmaxf((a), (b)), (c))
#define GAPA(MF, A0, A1, A2, A3, W0, W1, PW) do { MF; sacc += A0; sacc += A1; sacc += A2; sacc += A3; PIN(sacc); W0; W1; PIN(PW); SBAR(); } while (0)
#define EX(v) __builtin_amdgcn_exp2f(v)
#define DKR(OFF) (*(const LAS f32x4*)(dkp_ + (OFF)))
#define GAPB(MF, X, B, DKC, DKN, OFFN) do { MF; DKN = DKR(OFFN); X[B] = EX((X[B] - moff) - DKC[0]); X[B + 1] = EX((X[B + 1] - moff) - DKC[1]); X[B + 2] = EX((X[B + 2] - moff) - DKC[2]); X[B + 3] = EX((X[B + 3] - moff) - DKC[3]); PIN(X); SBAR(); } while (0)
#define VRD(i) do { vlo[i] = vtr(vp_ + (((i) >> 2) * 4096 + ((i) & 3) * 1024)); vhi[i] = vtr(vp_ + (((i) >> 2) * 4096 + ((i) & 3) * 1024 + 512)); } while (0)
#define KRD(G, j) do { if (G) { kload2(kf, kp0 + sl_next, j); SBAR(); } } while (0)
#define STEP(C0, C1, P0, P1, t, GK, GV, GL) do { SBAR(); \
    const lds_cptr vp_ = vp0 + sl_prev; \
    VRD(0); SBAR(); float sacc = (P0[0] + P0[1]); \
    GAPA(C0 = __builtin_amdgcn_mfma_f32_32x32x16_bf16(kf[0], qr[0], negm, 0, 0, 0), P0[2], P0[3], P0[4], P0[5],     pw0[0] = PKW(P0, 0), pw0[1] = PKW(P0, 2), pw0); \
    VRD(4); SBAR(); GAPA(C1 = __builtin_amdgcn_mfma_f32_32x32x16_bf16(kf[1], qr[0], negm, 0, 0, 0), P0[6], P0[7], P0[8], P0[9],     pw0[2] = PKW(P0, 4), pw0[3] = PKW(P0, 6), pw0); \
    VRD(1); SBAR(); GAPA(C0 = __builtin_amdgcn_mfma_f32_32x32x16_bf16(kf[2], qr[1], C0, 0, 0, 0),   P0[10], P0[11], P0[12], P0[13], pw1[0] = PKW(P0, 8), pw1[1] = PKW(P0, 10), pw1); \
    VRD(5); SBAR(); GAPA(C1 = __builtin_amdgcn_mfma_f32_32x32x16_bf16(kf[3], qr[1], C1, 0, 0, 0),   P0[14], P0[15], P1[0], P1[1],   pw1[2] = PKW(P0, 12), pw1[3] = PKW(P0, 14), pw1); \
    VRD(2); SBAR(); GAPA(C0 = __builtin_amdgcn_mfma_f32_32x32x16_bf16(kf[4], qr[2], C0, 0, 0, 0),   P1[2], P1[3], P1[4], P1[5],     pw2[0] = PKW(P1, 0), pw2[1] = PKW(P1, 2), pw2); \
    VRD(6); SBAR(); GAPA(C1 = __builtin_amdgcn_mfma_f32_32x32x16_bf16(kf[5], qr[2], C1, 0, 0, 0),   P1[6], P1[7], P1[8], P1[9],     pw2[2] = PKW(P1, 4), pw2[3] = PKW(P1, 6), pw2); \
    VRD(3); SBAR(); GAPA(C0 = __builtin_amdgcn_mfma_f32_32x32x16_bf16(kf[6], qr[3], C0, 0, 0, 0),   P1[10], P1[11], P1[12], P1[13], pw3[0] = PKW(P1, 8), pw3[1] = PKW(P1, 10), pw3); \
    VRD(7); SBAR(); GAPA(C1 = __builtin_amdgcn_mfma_f32_32x32x16_bf16(kf[7], qr[3], C1, 0, 0, 0),   P1[14], P1[15], 0.f, 0.f,       pw3[2] = PKW(P1, 12), pw3[3] = PKW(P1, 14), pw3); \
    l_reg += sacc; \
    if (GK) { DMA_K((t) + 3, sl_cur); } if (GV) { DMA_V((t) + 1, sl_next); } \
    CMASK(C0, C1, t); \
    const LAS float* dkp_ = c2s + 64 * (t); f32x4 dkA_ = DKR(0), dkB_; \
    { float a = MX3(C0[0], C0[1], C1[0]), b = MX3(C0[2], C0[3], C1[1]); a = MX3(a, C1[2], C1[3]); \
      _Pragma("unroll") for (int r = 4; r < 16; r += 4) { a = MX3(a, C0[r], C0[r + 1]); b = MX3(b, C0[r + 2], C0[r + 3]); a = MX3(a, C1[r], C1[r + 1]); b = MX3(b, C1[r + 2], C1[r + 3]); } \
      float rm = __builtin_fmaxf(a, b); { auto rr = __builtin_amdgcn_permlane32_swap(__float_as_uint(rm), __float_as_uint(rm), false, false); rm = __builtin_fmaxf(__uint_as_float(rr[0]), __uint_as_float(rr[1])); } \
      moff = mq + c2t[t]; rm -= moff; \
      resc = false; \
      if (__builtin_expect(__any(rm > (float)THRL), 0)) { const float dl = __builtin_fmaxf(rm, 0.f); mq += dl; moff += dl; \
        const float f = __builtin_amdgcn_exp2f(-dl); l_reg *= f; if (hi == 0) wsf[r32] = f; resc = true; } } \
    SBAR(); \
    GAPB(o[0] = __builtin_amdgcn_mfma_f32_32x32x16_bf16(PAF(0), VFR(0), o[0], 0, 0, 0), C0, 0, dkA_, dkB_, 8); \
    GAPB(o[1] = __builtin_amdgcn_mfma_f32_32x32x16_bf16(PAF(0), VFR(4), o[1], 0, 0, 0), C0, 4, dkB_, dkA_, 16); \
    KRD(GL, 0); GAPB(o[0] = __builtin_amdgcn_mfma_f32_32x32x16_bf16(PAF(1), VFR(1), o[0], 0, 0, 0), C0, 8, dkA_, dkB_, 24); \
    KRD(GL, 1); GAPB(o[1] = __builtin_amdgcn_mfma_f32_32x32x16_bf16(PAF(1), VFR(5), o[1], 0, 0, 0), C0, 12, dkB_, dkA_, 32); \
    KRD(GL, 2); GAPB(o[0] = __builtin_amdgcn_mfma_f32_32x32x16_bf16(PAF(2), VFR(2), o[0], 0, 0, 0), C1, 0, dkA_, dkB_, 40); \
    KRD(GL, 3); GAPB(o[1] = __builtin_amdgcn_mfma_f32_32x32x16_bf16(PAF(2), VFR(6), o[1], 0, 0, 0), C1, 4, dkB_, dkA_, 48); \
    GAPB(o[0] = __builtin_amdgcn_mfma_f32_32x32x16_bf16(PAF(3), VFR(3), o[0], 0, 0, 0), C1, 8, dkA_, dkB_, 56); \
    GAPB(o[1] = __builtin_amdgcn_mfma_f32_32x32x16_bf16(PAF(3), VFR(7), o[1], 0, 0, 0), C1, 12, dkB_, dkA_, 56); \
    } while (0)
    int t = 1;
#undef CMASK
#define CMASK(P0, P1, t) do { } while (0)
    for (; t + 6 < NT; t += 2) {
        STEP(pB0, pB1, pA0, pA1, t, true, true, true);     WAIT_BAR(2); RESC(); ROT();
        STEP(pA0, pA1, pB0, pB1, t + 1, true, true, true); WAIT_BAR(2); RESC(); ROT();
    }
#undef CMASK
#define CMASK(P0, P1, t) do { int jb_ = (t) - (NT - 5); if (jb_ >= 0) cmask(P0, P1, jb_, qrel, hi); } while (0)
#define ENDW(tt) do { if ((tt) + 3 < NT) { WAIT_BAR(2); } else if ((tt) + 2 < NT) { WAIT_BAR(1); } else { WAIT_BAR(0); } } while (0)
    for (; t + 1 < NT; t += 2) {
        STEP(pB0, pB1, pA0, pA1, t, (t + 3 < NT), (t + 1 < NT), (t + 1 < NT));         ENDW(t);     RESC(); ROT();
        STEP(pA0, pA1, pB0, pB1, t + 1, (t + 4 < NT), (t + 2 < NT), (t + 2 < NT));     ENDW(t + 1); RESC(); ROT();
    }
    STEP(pB0, pB1, pA0, pA1, NT - 1, false, false, false); RESC();
    { float sacc = pB0[0] + pB0[1]; _Pragma("unroll") for (int r = 2; r < 16; ++r) sacc += pB0[r]; _Pragma("unroll") for (int r = 0; r < 16; ++r) sacc += pB1[r]; l_reg += sacc;
      pw0 = (u32x4){PKW(pB0, 0), PKW(pB0, 2), PKW(pB0, 4), PKW(pB0, 6)}; pw1 = (u32x4){PKW(pB0, 8), PKW(pB0, 10), PKW(pB0, 12), PKW(pB0, 14)}; pw2 = (u32x4){PKW(pB1, 0), PKW(pB1, 2), PKW(pB1, 4), PKW(pB1, 6)}; pw3 = (u32x4){PKW(pB1, 8), PKW(pB1, 10), PKW(pB1, 12), PKW(pB1, 14)};
      SBAR(); pv(o, vb0 + sl_cur, PAF(0), PAF(1), PAF(2), PAF(3)); }
#undef PKW
#undef PAF
#undef VFR
#undef PIN
#undef MX3
#undef GAPA
#undef GAPB
#undef EX
#undef DKR
#undef VRD
#undef KRD
#undef STEP
#undef ENDW
    { auto rr = __builtin_amdgcn_permlane32_swap(__float_as_uint(l_reg), __float_as_uint(l_reg), false, false); l_reg = __uint_as_float(rr[0]) + __uint_as_float(rr[1]); }
    if (hi == 0) wsf[32 + r32] = l_reg; asm volatile("s_waitcnt lgkmcnt(0)" ::: "memory");
    float rli[16];
#pragma unroll
    for (int r = 0; r < 16; ++r) rli[r] = __builtin_amdgcn_rcpf(wsf[32 + crow(r, hi)]);
    bf16* Ow = O + (rowbase + q0 + wid * QBLK) * DM + h * D;
    { bf16* stg = (bf16*)(shm + LDS_OST) + wid * 2048;
#pragma unroll
      for (int r = 0; r < 16; ++r) { const int orow = crow(r, hi);
#pragma unroll
        for (int d0 = 0; d0 < 2; ++d0) stg[orow * 64 + d0 * 32 + r32] = __float2bfloat16(o[d0][r] * rli[r]); }
      asm volatile("s_waitcnt lgkmcnt(0)" ::: "memory");
#pragma unroll
      for (int i = 0; i < 4; ++i) { const int row = i * 8 + (lane >> 3), ch = lane & 7; const u32x4 v = *(const u32x4*)(stg + row * 64 + ch * 8); if (!DRY || v.x == 0x12345679u) *(u32x4*)(Ow + (long)row * DM + ch * 8) = v; } }
    asm volatile("s_waitcnt lgkmcnt(0)\n\ts_barrier" ::: "memory");
#undef DMA_K
#undef DMA_V
#undef TCL
#undef CMASK
#undef EXD
#undef START
#undef RESC
#undef ROT
}
#undef SBAR
#undef WAIT_BAR
}

constexpr int RING_BYTES = 131072;
constexpr int LDS_BYTES = 147456;

__device__ __forceinline__ void tr_item(const float* W, int ldw, int K, int k0, int nvalid, const float* gain, bf16_t* dst, LAS float* scr, int lane) {
    float tv[32];
#pragma unroll
    for (int i = 0; i < 32; ++i) { const int kk = 2 * i + (lane >> 5), c = lane & 31; tv[i] = (c < nvalid) ? W[(size_t)(k0 + kk) * ldw + c] : 0.f; }
#pragma unroll
    for (int i = 0; i < 32; ++i) { const int kk = 2 * i + (lane >> 5), c = lane & 31; float v = tv[i]; if (gain) v *= gain[k0 + kk]; scr[kk * 33 + c] = v; }
    LDS_WAIT(); asm volatile("" ::: "memory");
    const int c8 = lane & 7;
#pragma unroll
    for (int j = 0; j < 4; ++j) { const int n = (lane >> 3) + 8 * j; const LAS float* s = scr + (8 * c8) * 33 + n;
        u32x4 o; o.x = cvt_pk_bf16(s[0 * 33], s[1 * 33]); o.y = cvt_pk_bf16(s[2 * 33], s[3 * 33]); o.z = cvt_pk_bf16(s[4 * 33], s[5 * 33]); o.w = cvt_pk_bf16(s[6 * 33], s[7 * 33]);
        *(u32x4*)(dst + (size_t)n * K + k0 + 8 * c8) = o; }
    LDS_WAIT(); asm volatile("" ::: "memory");
}
enum MapMode { MAP_ID = 0, MAP_SWA, MAP_SWB, MAP_H64, MAP_ROT };
__device__ __forceinline__ int map_row(int mode, int nb) {
    const int c = 32 * nb;
    switch (mode) {
        case MAP_SWA: return 256 * (c >> 7) + (c & 127);
        case MAP_SWB: return 256 * (c >> 7) + 128 + (c & 127);
        case MAP_H64: { const int tl = c >> 8, ob = (c & 255) >> 5; return 256 * tl + 128 * (ob & 1) + 32 * (ob >> 1); }
        case MAP_ROT: { const int tl = c >> 8, ob = (c & 255) >> 5; return 256 * tl + 128 * ((ob >> 1) & 1) + 64 * (ob >> 2) + 32 * (ob & 1); }
        default: return c;
    }
}
struct Seg { const float* W; int ldw, K, ncols; const float* gain; size_t dst; int dstrow, mode; };
__device__ __forceinline__ Seg get_seg(const Params& p, int s) {
    switch (s) {
        case 0: return Seg{p.w1i, 2 * DFF, 1024, DFF, p.n1, WS_W1A, 0, MAP_SWA};
        case 1: return Seg{p.w1i + DFF, 2 * DFF, 1024, DFF, p.n1, WS_W1A, 0, MAP_SWB};
        case 2: return Seg{p.w1o, 1024, DFF, 1024, nullptr, WS_W1B, 0, MAP_ID};
        case 3: return Seg{p.win + 0, NINC, 1024, 1024, p.nm, WS_WIN, WIN_FOX, MAP_H64};
        case 4: return Seg{p.win + 1024, NINC, 1024, 1024, p.nm, WS_WIN, WIN_FOX + 1024, MAP_H64};
        case 5: return Seg{p.win + 2048, NINC, 1024, 1024, p.nm, WS_WIN, WIN_FOX + 2048, MAP_ID};
        case 6: return Seg{p.win + 3072, NINC, 1024, 16, p.nm, WS_WIN, WIN_RET + 3072, MAP_ID};
        case 7: return Seg{p.win + 3088, NINC, 1024, 512, p.nm, WS_WIN, WIN_RET + 0, MAP_ROT};
        case 8: return Seg{p.win + 3600, NINC, 1024, 512, p.nm, WS_WIN, WIN_RET + 512, MAP_ROT};
        case 9: return Seg{p.win + 4112, NINC, 1024, 1024, p.nm, WS_WIN, WIN_RET + 1024, MAP_ID};
        case 10: return Seg{p.win + 5136, NINC, 1024, 1024, p.nm, WS_WIN, WIN_RET + 2048, MAP_ID};
        case 11: return Seg{p.win + 6160, NINC, 1024, 1024, p.nm, WS_WIN, WIN_GA, MAP_ID};
        case 12: return Seg{p.win + 7184, NINC, 1024, 1024, p.nm, WS_WIN, WIN_GB, MAP_ID};
        case 13: return Seg{p.wof, 1024, 1024, 1024, nullptr, WS_WOF, 0, MAP_ID};
        case 14: return Seg{p.wor, 1024, 1024, 1024, nullptr, WS_WOR, 0, MAP_ID};
        case 15: return Seg{p.wout, 1024, 1024, 1024, nullptr, WS_WOUT, 0, MAP_ID};
        case 16: return Seg{p.w2i, 2 * DFF, 1024, DFF, p.n2, WS_W2A, 0, MAP_SWA};
        case 17: return Seg{p.w2i + DFF, 2 * DFF, 1024, DFF, p.n2, WS_W2A, 0, MAP_SWB};
        default: return Seg{p.w2o, 1024, DFF, 1024, nullptr, WS_W2B, 0, MAP_ID};
    }
}
__device__ __forceinline__ int seg_items(int s) {
    switch (s) {
        case 0: case 1: case 16: case 17: return 16 * 88;
        case 2: case 18: return 44 * 32;
        case 6: return 16;
        case 7: case 8: return 16 * 16;
        default: return 16 * 32;
    }
}
__device__ __forceinline__ void convert_range(const Params& p, LAS float* scr, int s_lo, int s_hi, int worker, int nworkers, int lane) {
    int total = 0;
#pragma unroll 1
    for (int s = s_lo; s <= s_hi; ++s) total += seg_items(s);
#pragma unroll 1
    for (int it = worker; it < total; it += nworkers) {
        int r = it, s = s_lo;
        while (r >= seg_items(s)) { r -= seg_items(s); ++s; }
        const Seg sg = get_seg(p, s);
        const int nblk = (sg.ncols + 31) / 32, kb = r / nblk, nb = r % nblk;
        const int nvalid = sg.ncols - 32 * nb < 32 ? sg.ncols - 32 * nb : 32;
        bf16_t* dst = (bf16_t*)(p.ws + sg.dst) + (size_t)(sg.dstrow + map_row(sg.mode, nb)) * sg.K;
        tr_item(sg.W + 32 * nb, sg.ldw, sg.K, 64 * kb, nvalid, sg.gain, dst, scr, lane);
    }
}
__device__ __forceinline__ void p0_prologue(const KP kp_, LAS unsigned char* lds, int vcu, int G, int tid, int wid, int lane) {
    const Params p = ldp(kp_);
    LAS float* scr = (LAS float*)(lds + wid * 16384);
    const int gw = vcu * 8 + wid, NGW = G * 8;
    convert_range(p, scr, 0, 1, gw, NGW, lane);
    { u32x4* z = (u32x4*)((bf16_t*)(p.ws + WS_WIN) + (size_t)(WIN_RET + 3072 + 32) * 1024); const int nz = 224 * 1024 * 2 / 16;
      for (int i = (vcu * 512 + tid); i < nz; i += G * 512) z[i] = (u32x4){0u, 0u, 0u, 0u}; }
    { bf16_t* XB = (bf16_t*)(p.ws + WS_XB); float* S0 = (float*)(p.ws + WS_SSQ0);
      for (int row0 = gw; row0 < MP; row0 += 2 * NGW) {
        f32x4 v[2][4]; float s[2];
#pragma unroll
        for (int h = 0; h < 2; ++h) { const int row = row0 + h * NGW; const int b = row / PP, pidx = row - b * PP;
#pragma unroll
            for (int j = 0; j < 4; ++j) { v[h][j] = (f32x4){0.f, 0.f, 0.f, 0.f};
                if (row < MP) { if (pidx >= 128) v[h][j] = *((const f32x4*)(p.x + ((size_t)(b * SEQ + pidx - 128)) * DM) + lane + 64 * j);
                    else if (pidx >= 112) v[h][j] = *((const f32x4*)(p.meta + (size_t)(pidx - 112) * DM) + lane + 64 * j); } } }
#pragma unroll
        for (int h = 0; h < 2; ++h) { s[h] = 0.f;
#pragma unroll
            for (int j = 0; j < 4; ++j) s[h] += (v[h][j][0] * v[h][j][0] + v[h][j][1] * v[h][j][1]) + (v[h][j][2] * v[h][j][2] + v[h][j][3] * v[h][j][3]);
            s[h] = wave_sum(s[h]); }
#pragma unroll
        for (int h = 0; h < 2; ++h) { const int row = row0 + h * NGW; if (row < MP) {
            u32x2* o8 = (u32x2*)(XB + (size_t)row * DM) + lane;
#pragma unroll
            for (int j = 0; j < 4; ++j) o8[64 * j] = pack4(v[h][j]);
            if (lane < 16) S0[(size_t)row * 16 + lane] = (lane == 0) ? s[h] : 0.f; } } } }
    { float* S1 = (float*)(p.ws + WS_SSQ1); for (int i = vcu * 512 + tid; i < NB * 2048; i += G * 512) S1[(size_t)(i >> 11) * PP * 16 + (i & 2047)] = 0.f; }
    { float* COS = (float*)(p.ws + WS_COS); float* SIN = (float*)(p.ws + WS_SIN);
      for (int i = vcu * 512 + tid; i < PP * 64; i += G * 512) { const int pidx = i >> 6, fi = i & 63;
        const float inv = exp2f(-(float)fi * (13.287712379549449f / 64.0f));
        const float ang = (float)(pidx - 112) * inv;
        const double a = (double)ang; const double kq = rint(a * 0.15915494309189535); const float red = (float)(a - kq * 6.283185307179586);
        COS[i] = __cosf(red); SIN[i] = __sinf(red); } }
}

__device__ __forceinline__ void thin_g2(const KP kp_, LAS unsigned char* lds, int bx, int wid, int lane) {
    if (bx >= 64) return;
    const Params p = ldp(kp_);
    const int l15 = lane & 15, g = lane >> 4, tile = bx, n0 = tile * 16;
    const bf16_t* wp = (const bf16_t*)(p.ws + WS_W1B) + (size_t)(n0 + l15) * DFF + 352 * wid + 8 * g;
    const bf16_t* hp = (const bf16_t*)(p.ws + WS_HID) + (size_t)(112 + l15) * DFF + 352 * wid + 8 * g;
    f32x4 acc = (f32x4){0.f, 0.f, 0.f, 0.f};
    bf16x8 a[11], b[11];
#pragma unroll
    for (int i = 0; i < 11; ++i) { a[i] = *(const bf16x8*)(wp + 32 * i); b[i] = *(const bf16x8*)(hp + 32 * i); }
#pragma unroll
    for (int i = 0; i < 11; ++i) acc = __builtin_amdgcn_mfma_f32_16x16x32_bf16(a[i], b[i], acc, 0, 0, 0);
    LAS f32x4* part = (LAS f32x4*)lds;
    part[wid * 64 + lane] = acc;
    __syncthreads();
    if (wid == 0) {
#pragma unroll
        for (int w = 1; w < 8; ++w) acc += part[w * 64 + lane];
        const f32x4 base = *(const f32x4*)(p.meta + (size_t)l15 * DM + n0 + 4 * g);
        const f32x4 h = base + acc * 0.5f;
        float ss = (h[0] * h[0] + h[1] * h[1]) + (h[2] * h[2] + h[3] * h[3]);
        ss += __shfl_xor(ss, 16); ss += __shfl_xor(ss, 32);
        bf16_t* HB = (bf16_t*)(p.ws + WS_XB); float* S1 = (float*)(p.ws + WS_SSQ1);
#pragma unroll
        for (int bb = 0; bb < NB; ++bb) { const size_t row = (size_t)bb * PP + 112 + l15;
            *(u32x2*)(HB + row * DM + n0 + 4 * g) = pack4(h);
            if (g == 0) atomicAdd(S1 + row * 16 + (tile & 15), ss); }
    }
    __syncthreads();
}

__device__ __forceinline__ float lg2gamma(int hd) { return log2f(1.0f - exp2f(-5.0f - (float)hd)); }
__device__ __forceinline__ void ret_kv_phase(const KP kp_, int vcu, int G, int wid, int lane) {
    const Params p = ldp(kp_);
    const bf16_t* KT = (const bf16_t*)(p.ws + WS_KT); const bf16_t* VT = (const bf16_t*)(p.ws + WS_VT); bf16_t* KVR = (bf16_t*)(p.ws + WS_KVR);
    const int l15 = lane & 15, g = lane >> 4;
#pragma unroll 1
    for (int u = vcu; u < 16 * 32; u += G) {
        const int bh = u >> 5, c = u & 31, hd = bh & 3; const float lg = lg2gamma(hd);
        const int bhs = (c == 0) ? hd : bh;
        f32x4 acc[2][8];
#pragma unroll
        for (int a = 0; a < 2; ++a)
#pragma unroll
            for (int b = 0; b < 8; ++b) acc[a][b] = (f32x4){0.f, 0.f, 0.f, 0.f};
#pragma unroll 1
        for (int s = 0; s < 4; ++s) {
            const int ml = 32 * s + 8 * g, m0 = 128 * c + ml;
            bf16x8 a[2]; u32x4 raw[2]; bf16x8 bfr[8];
#pragma unroll
            for (int ti = 0; ti < 2; ++ti) raw[ti] = *(const u32x4*)(VT + ((size_t)(bhs * 256 + 32 * wid + 16 * ti + l15)) * PP + m0);
#pragma unroll
            for (int tj = 0; tj < 8; ++tj) bfr[tj] = *(const bf16x8*)(KT + ((size_t)(bhs * 128 + 16 * tj + l15)) * PP + m0);
            asm volatile("" ::: "memory");
            float z[8];
#pragma unroll
            for (int j = 0; j < 8; ++j) z[j] = exp2f(lg * (float)(127 - (ml + j)));
#pragma unroll
            for (int ti = 0; ti < 2; ++ti) { u32x4 w; w.x = cvt_pk_bf16(bf_lo(raw[ti].x) * z[0], bf_hi(raw[ti].x) * z[1]); w.y = cvt_pk_bf16(bf_lo(raw[ti].y) * z[2], bf_hi(raw[ti].y) * z[3]);
                w.z = cvt_pk_bf16(bf_lo(raw[ti].z) * z[4], bf_hi(raw[ti].z) * z[5]); w.w = cvt_pk_bf16(bf_lo(raw[ti].w) * z[6], bf_hi(raw[ti].w) * z[7]);
                a[ti] = __builtin_bit_cast(bf16x8, w); }
#pragma unroll
            for (int tj = 0; tj < 8; ++tj) {
                acc[0][tj] = __builtin_amdgcn_mfma_f32_16x16x32_bf16(bfr[tj], a[0], acc[0][tj], 0, 0, 0);
                acc[1][tj] = __builtin_amdgcn_mfma_f32_16x16x32_bf16(bfr[tj], a[1], acc[1][tj], 0, 0, 0); }
        }
        bf16_t* o = KVR + ((size_t)(bh * 33 + c)) * 32768;
#pragma unroll
        for (int ti = 0; ti < 2; ++ti)
#pragma unroll
            for (int tj = 0; tj < 8; ++tj) *(u32x2*)(o + (size_t)(32 * wid + 16 * ti + l15) * 128 + 16 * tj + 4 * g) = pack4(acc[ti][tj]);
    }
}
__device__ __forceinline__ void cumsum_phase(const KP kp_, LAS unsigned char* lds, int vcu, int G, int wid, int lane) {
    const Params p = ldp(kp_);
    const float* LF = (const float*)(p.ws + WS_LOGF);
    LAS float* tot = (LAS float*)lds;
#pragma unroll 1
    for (int sq = vcu; sq < 64; sq += G) {
        const float* base = LF + (size_t)sq * PP; const float* base0 = LF + (size_t)(sq & 15) * PP; float* outp = (float*)(p.ws + WS_C2) + (size_t)sq * PP;
        const int cs = (wid * 66) >> 3, ce = ((wid + 1) * 66) >> 3;
        float inc[9]; float carry = 0.f;
#pragma unroll
        for (int k = 0; k < 9; ++k) { const int i = cs + k; float v = 0.f;
            if (i < ce) v = (i < 2) ? base0[64 * i + lane] : base[64 * i + lane];
            inc[k] = v; }
#pragma unroll
        for (int k = 0; k < 9; ++k) { float x = inc[k];
#pragma unroll
            for (int o = 1; o < 64; o <<= 1) { const float t = __shfl_up(x, o); if (lane >= o) x += t; }
            inc[k] = carry + x; carry += __shfl(x, 63); }
        if (lane == 0) tot[wid] = carry;
        __syncthreads();
        float pre = 0.f;
#pragma unroll
        for (int w = 0; w < 8; ++w) { const float t = tot[w]; if (w < wid) pre += t; }
#pragma unroll
        for (int k = 0; k < 9; ++k) { const int i = cs + k; if (i < ce) { const int pidx = 64 * i + lane; outp[pidx] = (pidx < 112) ? INFINITY : pre + inc[k]; } }
        __syncthreads();
    }
}
template <bool DRY> __device__ __forceinline__ void ret_scan_phase(const KP kp_, int G, int tid) {
    const Params p = ldp(kp_);
    bf16_t* KVR = (bf16_t*)(p.ws + WS_KVR);
#pragma unroll 1
    for (int it = blockIdx.x * 512 + tid; it < 131072; it += G * 512) {
        const int bh = it >> 13, off = (it & 8191) * 4, hd = bh & 3;
        const float Gm = exp2f(128.0f * lg2gamma(hd));
        u32x2* base = (u32x2*)(KVR + (size_t)bh * 33 * 32768 + off);
        u32x2 v[33];
#pragma unroll
        for (int c = 0; c < 32; ++c) v[c] = base[(size_t)c * 8192];
        v[32] = (u32x2){0u, 0u};
        f32x4 R = (f32x4){0.f, 0.f, 0.f, 0.f};
#pragma unroll
        for (int c = 0; c < 33; ++c) { const u32x2 rw = pack4(R); if (!DRY || rw.x == 0x12345679u) base[(size_t)c * 8192] = rw;
            R[0] = R[0] * Gm + bf_lo(v[c].x); R[1] = R[1] * Gm + bf_hi(v[c].x); R[2] = R[2] * Gm + bf_lo(v[c].y); R[3] = R[3] * Gm + bf_hi(v[c].y); }
    }
}
template <bool DRY> __device__ __forceinline__ void ret_out_phase(const KP kp_, LAS unsigned char* lds, int vcu, int G, int tid, int wid, int lane) {
    const Params p = ldp(kp_);
    const bf16_t* RQ = (const bf16_t*)(p.ws + WS_RQ); const bf16_t* RK = (const bf16_t*)(p.ws + WS_RK); const bf16_t* VT = (const bf16_t*)(p.ws + WS_VT);
    const bf16_t* KVR = (const bf16_t*)(p.ws + WS_KVR); bf16_t* YB = (bf16_t*)(p.ws + WS_SRG);
    const int l15 = lane & 15, g = lane >> 4;
    constexpr int PITCH = 272, VOFF = 256 * PITCH;
#pragma unroll 1
    for (int u = vcu; u < 512; u += G) {
        const int bh = u >> 5, c = (u & 31) + 1, b = bh >> 2, hd = bh & 3; const float lg = lg2gamma(hd);
        const int nl = 16 * wid + l15;
        const size_t rowq = (size_t)b * PP + 128 * c + nl;
        { const u32x4* rsrc = (const u32x4*)(KVR + ((size_t)(bh * 33 + c)) * 32768);
          u32x4 rr[8], vv[8];
#pragma unroll
          for (int i = 0; i < 8; ++i) { const int q = tid + 512 * i; rr[i] = rsrc[q];
              vv[i] = *(const u32x4*)(VT + ((size_t)(bh * 256 + (q >> 4))) * PP + 128 * c + (q & 15) * 8); }
#pragma unroll
          for (int i = 0; i < 8; ++i) { const int q = tid + 512 * i; const int off = (q >> 4) * PITCH + (q & 15) * 16;
              *(LAS u32x4*)(lds + off) = rr[i]; *(LAS u32x4*)(lds + VOFF + off) = vv[i]; } }
        bf16x8 qf[4];
#pragma unroll
        for (int s = 0; s < 4; ++s) qf[s] = *(const bf16x8*)(RQ + rowq * 512 + hd * 128 + 32 * s + 8 * g);
        __syncthreads();
        f32x4 acc[16];
#pragma unroll
        for (int ti = 0; ti < 16; ++ti) acc[ti] = (f32x4){0.f, 0.f, 0.f, 0.f};
        const LAS unsigned char* rbase = lds + l15 * PITCH + 16 * g;
#pragma unroll
        for (int s = 0; s < 4; ++s)
#pragma unroll
            for (int ti = 0; ti < 16; ++ti) { const bf16x8 a = *(const LAS bf16x8*)(rbase + 16 * ti * PITCH + 64 * s);
                acc[ti] = __builtin_amdgcn_mfma_f32_16x16x32_bf16(a, qf[s], acc[ti], 0, 0, 0); }
        const float xi = exp2f(lg * (float)(nl + 1));
#pragma unroll
        for (int ti = 0; ti < 16; ++ti) acc[ti] = acc[ti] * xi;
        const int nmb = (wid >> 1) + 1;
        const bf16_t* kp = RK + ((size_t)b * PP + 128 * c + l15) * 512 + hd * 128 + 8 * g;
        bf16x8 k0[4], k1[4], kn0[4], kn1[4];
#pragma unroll
        for (int s = 0; s < 4; ++s) { k0[s] = *(const bf16x8*)(kp + 32 * s); k1[s] = *(const bf16x8*)(kp + 16 * 512 + 32 * s); }
#pragma unroll 1
        for (int mb = 0; mb < nmb; ++mb) {
            f32x4 t0 = (f32x4){0.f, 0.f, 0.f, 0.f}, t1 = t0;
            { const bf16_t* kq = kp + (size_t)(mb + 1 < nmb ? mb + 1 : mb) * 32 * 512;
#pragma unroll
              for (int s = 0; s < 4; ++s) { kn0[s] = *(const bf16x8*)(kq + 32 * s); kn1[s] = *(const bf16x8*)(kq + 16 * 512 + 32 * s); } }
#pragma unroll
            for (int s = 0; s < 4; ++s) { t0 = __builtin_amdgcn_mfma_f32_16x16x32_bf16(k0[s], qf[s], t0, 0, 0, 0); t1 = __builtin_amdgcn_mfma_f32_16x16x32_bf16(k1[s], qf[s], t1, 0, 0, 0); }
#pragma unroll
            for (int s = 0; s < 4; ++s) { k0[s] = kn0[s]; k1[s] = kn1[s]; }
#pragma unroll
            for (int r = 0; r < 4; ++r) { const int d0 = nl - (32 * mb + 4 * g + r), d1 = d0 - 16;
                t0[r] = (d0 >= 0) ? t0[r] * exp2f(lg * (float)d0) : 0.f; t1[r] = (d1 >= 0) ? t1[r] * exp2f(lg * (float)d1) : 0.f; }
            const u32x2 s0 = pack4(t0), s1 = pack4(t1);
            const bf16x8 sb = __builtin_bit_cast(bf16x8, ((u32x4){s0.x, s0.y, s1.x, s1.y}));
            const LAS unsigned char* vbase = lds + VOFF + l15 * PITCH + 64 * mb + 8 * g;
#pragma unroll
            for (int ti = 0; ti < 16; ++ti) { const u32x2 lo = *(const LAS u32x2*)(vbase + 16 * ti * PITCH), hi2 = *(const LAS u32x2*)(vbase + 16 * ti * PITCH + 32);
                const bf16x8 a = __builtin_bit_cast(bf16x8, ((u32x4){lo.x, lo.y, hi2.x, hi2.y}));
                acc[ti] = __builtin_amdgcn_mfma_f32_16x16x32_bf16(a, sb, acc[ti], 0, 0, 0); }
        }
        float s = 0.f;
#pragma unroll
        for (int ti = 0; ti < 16; ++ti) s += (acc[ti][0] + acc[ti][1]) + (acc[ti][2] + acc[ti][3]);
        s += __shfl_xor(s, 16); s += __shfl_xor(s, 32);
        const float mean = s * (1.0f / 256.0f); float q = 0.f;
#pragma unroll
        for (int ti = 0; ti < 16; ++ti) { const f32x4 d = acc[ti] - mean; q += (d[0] * d[0] + d[1] * d[1]) + (d[2] * d[2] + d[3] * d[3]); }
        q += __shfl_xor(q, 16); q += __shfl_xor(q, 32);
        const float rstd = rsqrtf(q * (1.0f / 256.0f) + 1e-5f);
#pragma unroll
        for (int ti = 0; ti < 16; ++ti) { const int e0 = 16 * ti + 4 * g;
            const f32x4 gn = *(const f32x4*)(p.rgn + hd * 256 + e0);
            bf16_t* yp = YB + rowq * DM + hd * 256 + e0; const u32x2 sg = *(const u32x2*)yp;
            f32x4 o = (acc[ti] - mean) * rstd * gn; o[0] *= bf_lo(sg.x); o[1] *= bf_hi(sg.x); o[2] *= bf_lo(sg.y); o[3] *= bf_hi(sg.y);
            const u32x2 ow = pack4(o); if (!DRY || ow.x == 0x12345679u) *(u32x2*)yp = ow; }
        __syncthreads();
    }
}

#define XB_TMO      128
#define XB_XCNT(j)  (256  + 64 * (j))
#define XB_XSUB(j)  (1280 + 64 * (j))
#define XB_XGEN(j)  (2304 + 64 * (j))
#define XB_TOP      3328
#define XB_TOPGEN   3392
#define XCD_BAR_WORDS 3456
#define XB_SPIN_CAP (1u << 20)
constexpr size_t WS_BAR = 65536;
constexpr int LDS_MISC = 140000;
__device__ __forceinline__ unsigned xb_ld(unsigned* p)              { return __hip_atomic_load(p, __ATOMIC_RELAXED, __HIP_MEMORY_SCOPE_AGENT); }
__device__ __forceinline__ unsigned xb_add(unsigned* p, unsigned v) { return __hip_atomic_fetch_add(p, v, __ATOMIC_RELAXED, __HIP_MEMORY_SCOPE_AGENT); }
__device__ __forceinline__ unsigned xb_xcc_id() { return (unsigned)__builtin_amdgcn_s_getreg((3 << 11) | 20) & 0xFu; }
#define XB_SPIN(cond, bar) do { unsigned _sp = 0; while (cond) { __builtin_amdgcn_s_sleep(1); \
    if ((++_sp & 255u) == 0u) { if (xb_ld(&(bar)[XB_TMO])) break; if (_sp > XB_SPIN_CAP) { atomicAdd(&(bar)[XB_TMO], 1u); break; } } } } while (0)
__device__ __forceinline__ void xcd_barrier_complete(unsigned* bar, unsigned x, unsigned& nloc, unsigned& nx) {
    const unsigned G = gridDim.x * gridDim.y * gridDim.z;
    unsigned sum, cnt, mine, sp = 0u;
    for (;;) {
        sum = 0u; cnt = 0u; mine = 0u;
#pragma unroll
        for (unsigned j = 0; j < 16; ++j) { const unsigned c = xb_ld(&bar[XB_XCNT(j)]); sum += c; cnt += (c > 0u) ? 1u : 0u; mine = (j == x) ? c : mine; }
        if (sum == G) break;
        __builtin_amdgcn_s_sleep(1);
        if ((++sp & 255u) == 0u) { if (xb_ld(&bar[XB_TMO])) break; if (sp > XB_SPIN_CAP) { atomicAdd(&bar[XB_TMO], 1u); break; } }
    }
    nloc = mine > 0u ? mine : 1u; nx = cnt > 0u ? cnt : 1u;
}
__device__ __forceinline__ void xcd_barrier(unsigned* bar, volatile LAS unsigned* st) {
    asm volatile("s_waitcnt vmcnt(0)" ::: "memory");
    __syncthreads();
    if (threadIdx.x == 0) {
        const unsigned x = xb_xcc_id();
        __builtin_amdgcn_s_waitcnt(0);
        unsigned nloc = st[0], nx = st[1];
        if (nloc == 0u) { xcd_barrier_complete(bar, x, nloc, nx); st[0] = nloc; st[1] = nx; }
        const unsigned old = xb_add(&bar[XB_XSUB(x)], 1u);
        const unsigned gen = old / nloc;
        if (old + 1u == (gen + 1u) * nloc) {
            __builtin_amdgcn_fence(__ATOMIC_RELEASE, "agent");
            asm volatile("s_waitcnt vmcnt(0)" ::: "memory");
            const unsigned og = xb_add(&bar[XB_TOP], 1u);
            const unsigned tg = og / nx;
            if (og + 1u == (tg + 1u) * nx) xb_add(&bar[XB_TOPGEN], 1u);
            else XB_SPIN(xb_ld(&bar[XB_TOPGEN]) == tg, bar);
            __builtin_amdgcn_fence(__ATOMIC_ACQUIRE, "agent");
            xb_add(&bar[XB_XGEN(x)], 1u);
            asm volatile("s_waitcnt vmcnt(0)" ::: "memory");
        } else {
            XB_SPIN(xb_ld(&bar[XB_XGEN(x)]) == gen, bar);
            __builtin_amdgcn_fence(__ATOMIC_ACQUIRE, "agent");
            asm volatile("s_waitcnt vmcnt(0)" ::: "memory");
        }
    }
    __syncthreads();
}

extern __shared__ __attribute__((aligned(16))) unsigned char lds_raw[];
template <bool DRY> __device__ __forceinline__ void run_phase(const int ph) {
        const KP kp = kparams();
        int tid = threadIdx.x; asm volatile("" : "+v"(tid));
        int G = gridDim.x, bx = blockIdx.x; asm volatile("" : "+s"(G), "+s"(bx));
        LAS unsigned char* lds = (LAS unsigned char*)lds_raw;
        const int lane = tid & 63, wid = __builtin_amdgcn_readfirstlane(tid >> 6);
        const int vcu = (G % 8 == 0) ? (bx % 8) * (G / 8) + bx / 8 : bx;
        int gp = -1;
        switch (ph) {
            case 1: gp = pg8::GP_G1; break;
            case 2: gp = pg8::GP_G2; break;
            case 3: gp = pg8::GP_G3R; break;
            case 7: gp = pg8::GP_G3F; break;
            case 9: gp = pg8::GP_MIX; break;
            case 10: gp = pg8::GP_OUT; break;
            case 11: gp = pg8::GP_F2A; break;
            case 12: gp = pg8::GP_F2B; break;
            default: break;
        }
        if (gp >= 0) {
#ifndef NO_GEMM
            pg8::Epi E;
            pg8::Sched S; S.init(gp, G, bx);
            pg8::gemm_phase(lds, S, E);
            if (gp == pg8::GP_G2 && !DRY) thin_g2(kp, lds, bx, wid, lane);
            if (G == 256 && !DRY) {
                if (gp == pg8::GP_G1 && bx >= 172) { const Params p = ldp(kp); convert_range(p, (LAS float*)(lds + wid * 16384), 2, 10, (bx - 172) * 8 + wid, 84 * 8, lane); }
                if (gp == pg8::GP_G3R && bx >= 79) { const Params p = ldp(kp); convert_range(p, (LAS float*)(lds + wid * 16384), 11, 18, (bx - 79) * 8 + wid, 177 * 8, lane); }
            } else if (!DRY) {
                const Params p = ldp(kp);
                if (gp == pg8::GP_G1) convert_range(p, (LAS float*)(lds + wid * 16384), 2, 10, vcu * 8 + wid, G * 8, lane);
                if (gp == pg8::GP_G3R) convert_range(p, (LAS float*)(lds + wid * 16384), 11, 18, vcu * 8 + wid, G * 8, lane);
            }
#endif
        } else if (ph == 0) {
#ifndef NO_P0
            p0_prologue(kp, lds, vcu, G, tid, wid, lane);
#endif
        } else if (ph == 4) {
#ifndef NO_R1
            if (!DRY) cumsum_phase(kp, lds, vcu, G, wid, lane);
            ret_kv_phase(kp, vcu, G, wid, lane);
#endif
        } else if (ph == 5) {
#ifndef NO_R2
            ret_scan_phase<DRY>(kp, G, tid);
#endif
        } else if (ph == 6) {
#ifndef NO_R3
            ret_out_phase<DRY>(kp, lds, vcu, G, tid, wid, lane);
#endif
        } else if (ph == 8) {
#ifndef NO_ATTN
            unsigned char* ws = kp->ws;
            const attn_body::bf16* Qp = (const attn_body::bf16*)(ws + WS_Q); const attn_body::bf16* Kp = (const attn_body::bf16*)(ws + WS_K); const attn_body::bf16* Vp = (const attn_body::bf16*)(ws + WS_V);
            const float* C2 = (const float*)(ws + WS_C2);
            const int nun = (G == 256) ? 4 : (1024 - vcu + G - 1) / G;
#pragma unroll 1
            for (int i = 0; i < nun; ++i) {
                int bh, qb;
                if (G == 256) { const int s = vcu & 3; bh = vcu >> 2; qb = (i == 0) ? s : (i == 1) ? 7 - s : (i == 2) ? 8 + s : 15 - s; }
                else { const int idx = vcu + i * G; bh = idx >> 4; qb = idx & 15; }
                attn_body::attn_unit<32, DRY>(bh >> 4, bh & 15, qb, Qp, Kp, Vp, (const attn_body::bf16*)(ws + WS_KLEAD), (const attn_body::bf16*)(ws + WS_VLEAD), (attn_body::bf16*)(ws + WS_Q), C2, (char*)lds_raw);
            }
#endif
        }
}
#ifndef MULTI
#ifndef PROBE_PH
#define PROBE_PH -1
#endif
__global__ void __launch_bounds__(512, 2) fwd_megakernel(Params p_unused) {
    cg::grid_group grid = cg::this_grid();
    { volatile LAS unsigned* st = (volatile LAS unsigned*)((LAS unsigned char*)lds_raw + LDS_MISC);
      if (threadIdx.x == 0) { st[0] = 0u; st[1] = 0u; (void)xb_add((unsigned*)(kparams()->ws + WS_BAR) + XB_XCNT(xb_xcc_id()), 1u); }
      __syncthreads(); }
    if (gridDim.x > 65536u) grid.sync();
#pragma unroll 1
    for (int ph = 0; ph <= LAST_PHASE; ++ph) {
        if (PROBE_PH >= 0 && ph == PROBE_PH) { run_phase<true>(ph); xcd_barrier((unsigned*)(kparams()->ws + WS_BAR), (volatile LAS unsigned*)((LAS unsigned char*)lds_raw + LDS_MISC)); }
        run_phase<false>(ph);
        if (ph < 12) xcd_barrier((unsigned*)(kparams()->ws + WS_BAR), (volatile LAS unsigned*)((LAS unsigned char*)lds_raw + LDS_MISC));
    }
}
#else
template <int PH> __global__ void __launch_bounds__(512, 2) phase_kernel(Params p_unused) { run_phase<false>(PH); }
__global__ void __launch_bounds__(512, 2) gemm_kernel(Params p_unused, int ph) { run_phase<false>(ph == 1 ? 1 : ph == 2 ? 2 : ph == 3 ? 3 : ph == 7 ? 7 : ph == 9 ? 9 : ph == 10 ? 10 : ph == 11 ? 11 : 12); }
#endif

extern "C" void kernel_launch(void* const* d_in, const int* in_sizes, int n_in, void* d_out, int out_size, void* d_ws, size_t ws_size, hipStream_t stream) {
    static int grid = 0;
    if (grid == 0) {
        int dev = 0, cus = 0, per_cu = 0;
        if (hipGetDevice(&dev) != hipSuccess || hipDeviceGetAttribute(&cus, hipDeviceAttributeMultiprocessorCount, dev) != hipSuccess) { fprintf(stderr, "kernel_launch: device query failed\n"); grid = -1; return; }
#ifndef MULTI
        if (hipFuncSetAttribute((const void*)fwd_megakernel, hipFuncAttributeMaxDynamicSharedMemorySize, LDS_BYTES) != hipSuccess) { fprintf(stderr, "kernel_launch: hipFuncSetAttribute failed\n"); grid = -1; return; }
        if (hipOccupancyMaxActiveBlocksPerMultiprocessor(&per_cu, (const void*)fwd_megakernel, 512, LDS_BYTES) != hipSuccess || per_cu < 1) { fprintf(stderr, "kernel_launch: occupancy query says %d\n", per_cu); per_cu = 1; }
#else
        hipFuncSetAttribute((const void*)phase_kernel<0>, hipFuncAttributeMaxDynamicSharedMemorySize, LDS_BYTES);
        hipFuncSetAttribute((const void*)phase_kernel<4>, hipFuncAttributeMaxDynamicSharedMemorySize, LDS_BYTES);
        hipFuncSetAttribute((const void*)phase_kernel<5>, hipFuncAttributeMaxDynamicSharedMemorySize, LDS_BYTES);
        hipFuncSetAttribute((const void*)phase_kernel<6>, hipFuncAttributeMaxDynamicSharedMemorySize, LDS_BYTES);
        hipFuncSetAttribute((const void*)phase_kernel<8>, hipFuncAttributeMaxDynamicSharedMemorySize, LDS_BYTES);
        hipFuncSetAttribute((const void*)gemm_kernel, hipFuncAttributeMaxDynamicSharedMemorySize, LDS_BYTES);
#endif
        (void)hipGetLastError();
        grid = cus;
    }
    if (grid < 0) return;
    Params p{};
    p.x = (const float*)d_in[0]; p.meta = (const float*)d_in[1]; p.n1 = (const float*)d_in[2]; p.w1i = (const float*)d_in[3]; p.w1o = (const float*)d_in[4];
    p.nm = (const float*)d_in[5]; p.win = (const float*)d_in[6]; p.bfg = (const float*)d_in[7]; p.bgate = (const float*)d_in[8]; p.qn = (const float*)d_in[9];
    p.kn = (const float*)d_in[10]; p.wof = (const float*)d_in[11]; p.rgn = (const float*)d_in[12]; p.wor = (const float*)d_in[13]; p.wout = (const float*)d_in[14];
    p.n2 = (const float*)d_in[15]; p.w2i = (const float*)d_in[16]; p.w2o = (const float*)d_in[17];
    p.out = (float*)d_out; p.ws = (unsigned char*)d_ws;
#ifndef MULTI
    if (hipMemsetAsync((char*)d_ws + WS_BAR, 0, XCD_BAR_WORDS * 4, stream) != hipSuccess) { fprintf(stderr, "kernel_launch: memset failed\n"); return; }
    void* args[] = {&p};
    hipError_t e = hipLaunchCooperativeKernel((const void*)fwd_megakernel, dim3(grid), dim3(512), args, LDS_BYTES, stream);
    if (e != hipSuccess) fprintf(stderr, "cooperative launch failed: %s (grid %d)\n", hipGetErrorString(e), grid);
#else
    for (int ph = 0; ph <= LAST_PHASE; ++ph) {
        switch (ph) {
            case 0: hipLaunchKernelGGL(phase_kernel<0>, dim3(grid), dim3(512), LDS_BYTES, stream, p); break;
            case 4: hipLaunchKernelGGL(phase_kernel<4>, dim3(grid), dim3(512), LDS_BYTES, stream, p); break;
            case 5: hipLaunchKernelGGL(phase_kernel<5>, dim3(grid), dim3(512), LDS_BYTES, stream, p); break;
            case 6: hipLaunchKernelGGL(phase_kernel<6>, dim3(grid), dim3(512), LDS_BYTES, stream, p); break;
            case 8: hipLaunchKernelGGL(phase_kernel<8>, dim3(grid), dim3(512), LDS_BYTES, stream, p); break;
            default: hipLaunchKernelGGL(gemm_kernel, dim3(grid), dim3(512), LDS_BYTES, stream, p, ph); break;
        }
    }
#endif
}
```
